# Optimizing an MI355X kernel written in HIP

```python
import math, functools
import jax, jax.numpy as jnp
from jax import lax
import numpy as np

D_MODEL = 2048
BATCH = 4
SEQ = 4096
DEPTH = 2

CTX_LEN = 256
GRID_W = 64
N_BRANCH = 4
BR_WIDTH = D_MODEL // N_BRANCH
HEAD_DIM = 128
N_HEADS = BR_WIDTH // HEAD_DIM
S5_GROUP = 16
S5_GROUPS = BR_WIDTH // S5_GROUP
S5_STATE = 64
S5_DT_MIN = 1e-3
S5_DT_MAX = 1e-1
D_FF = 4 * D_MODEL
CHUNK = 64
CONV_K = 3
NORM_EPS = 1e-6
NEG_BIG = -1e30
F_TINY = 1e-30
RET_DECAY_EXP0 = 5.0
MLSTM_F_BIAS_LO = 3.0
MLSTM_F_BIAS_HI = 6.0
N_MOD = 6

IN_SPLITS = (
    BR_WIDTH, BR_WIDTH, BR_WIDTH, BR_WIDTH, BR_WIDTH,
    BR_WIDTH, BR_WIDTH, BR_WIDTH, BR_WIDTH,
    BR_WIDTH,
    2 * BR_WIDTH, BR_WIDTH, BR_WIDTH, 4 * N_HEADS,
    N_BRANCH * D_MODEL,
)
IN_WIDTH = sum(IN_SPLITS)

kernel_name = "hybrid_gated_recurrent_diffusion_block"


def _split_cols(p):
    idx = np.cumsum(np.array(IN_SPLITS))[:-1].tolist()
    return jnp.split(p, idx, axis=-1)


def rmsnorm(x, g):
    xf = x.astype(jnp.float32)
    y = xf * lax.rsqrt(jnp.mean(jnp.square(xf), axis=-1, keepdims=True) + NORM_EPS)
    return (y * g.astype(jnp.float32)).astype(x.dtype)


def head_rmsnorm(o, g):
    b, l, h, d = o.shape
    return rmsnorm(o, g.reshape(h, d)).reshape(b, l, h * d)


def heads(t):
    return t.reshape(t.shape[:2] + (N_HEADS, HEAD_DIM))


def modulate(h, shift, scale):
    return h * (1.0 + scale) + shift


def _chunks(t):
    b, l, h = t.shape[:3]
    t = t.astype(jnp.float32).reshape((b, l // CHUNK, CHUNK, h) + t.shape[3:])
    return jnp.moveaxis(t, (1, 2), (0, 3))


def _unchunk(t, dtype):
    n, b, h, c = t.shape[:4]
    t = jnp.moveaxis(t, (0, 3), (1, 2))
    return t.reshape((b, n * c, h) + t.shape[4:]).astype(dtype)


def hgrn2_forget(z, lb):
    zf = z.astype(jnp.float32)
    lbf = lb.astype(jnp.float32)
    f = lbf + (1.0 - lbf) * jax.nn.sigmoid(zf)
    log_f = jnp.log(jnp.maximum(f, F_TINY))
    k = (1.0 - lbf) * jax.nn.sigmoid(-zf)
    return log_f, k


def hgrn2_scan(q, k, v, log_f, state):
    dtype = q.dtype
    tril = jnp.tril(jnp.ones((CHUNK, CHUNK), dtype=bool))[:, :, None]

    def step(s, blk):
        qb, kb, vb, fb = blk
        cum = jnp.cumsum(fb, axis=2)
        diff = cum[:, :, :, None, :] - cum[:, :, None, :, :]
        decay = jnp.where(tril, jnp.exp(jnp.where(tril, diff, 0.0)), 0.0)
        scores = jnp.einsum("bhtd,bhsd,bhtsd->bhts", qb, kb, decay)
        out = (jnp.einsum("bhts,bhsv->bhtv", scores, vb)
               + jnp.einsum("bhtd,bhdv->bhtv", qb * jnp.exp(cum), s))
        tail = cum[:, :, -1:, :]
        s = (jnp.exp(tail[:, :, 0, :, None]) * s
             + jnp.einsum("bhsd,bhsv->bhdv", kb * jnp.exp(tail - cum), vb))
        return s, out

    state, out = lax.scan(step, state, (_chunks(q), _chunks(k), _chunks(v), _chunks(log_f)))
    return _unchunk(out, dtype), state


def retention_scan(q, k, v, state, *, log_gamma):
    dtype = q.dtype
    lg = log_gamma.astype(jnp.float32)[:, None]
    t = jnp.arange(CHUNK, dtype=jnp.float32)
    rel = t[:, None] - t[None, :]
    intra = jnp.where(rel >= 0, jnp.exp(lg[:, :, None] * jnp.maximum(rel, 0.0)), 0.0)
    from_state = jnp.exp(lg * (t + 1.0))
    into_state = jnp.exp(lg * (CHUNK - 1.0 - t))
    chunk_decay = jnp.exp(lg * CHUNK)

    def step(s, blk):
        qb, kb, vb = blk
        scores = jnp.einsum("bhtd,bhsd->bhts", qb, kb) * intra
        out = (jnp.einsum("bhts,bhsv->bhtv", scores, vb)
               + from_state[:, :, None] * jnp.einsum("bhtd,bhdv->bhtv", qb, s))
        s = (chunk_decay[:, :, None] * s
             + jnp.einsum("bhsd,bhsv->bhdv", kb * into_state[:, :, None], vb))
        return s, out

    state, out = lax.scan(step, state, (_chunks(q), _chunks(k), _chunks(v)))
    return _unchunk(out, dtype), state


def mlstm_scan(q, k, v, log_i, log_f, state):
    dtype = q.dtype
    tril = jnp.tril(jnp.ones((CHUNK, CHUNK), dtype=bool))

    def step(carry, blk):
        cmat, nvec, m = carry
        qb, kb, vb, ib, fb = blk
        cum = jnp.cumsum(fb, axis=-1)
        logw = jnp.where(tril, cum[..., :, None] - cum[..., None, :] + ib[..., None, :], NEG_BIG)
        from_state = cum + m[..., None]
        m_t = jnp.maximum(from_state, jnp.max(logw, axis=-1))
        w = jnp.exp(logw - m_t[..., None])
        w_state = jnp.exp(from_state - m_t)
        scores = jnp.einsum("bhtd,bhsd->bhts", qb, kb) * w
        num = (jnp.einsum("bhts,bhsv->bhtv", scores, vb)
               + w_state[..., None] * jnp.einsum("bhtd,bhdv->bhtv", qb, cmat))
        den = jnp.sum(scores, axis=-1) + w_state * jnp.einsum("bhtd,bhd->bht", qb, nvec)
        h = num / jnp.maximum(jnp.abs(den), jnp.exp(-m_t))[..., None]
        total = cum[..., -1]
        logw_end = total[..., None] - cum + ib
        m_new = jnp.maximum(total + m, jnp.max(logw_end, axis=-1))
        w_end = jnp.exp(logw_end - m_new[..., None])
        keep = jnp.exp(total + m - m_new)
        cmat = keep[..., None, None] * cmat + jnp.einsum("bhs,bhsd,bhsv->bhdv", w_end, kb, vb)
        nvec = keep[..., None] * nvec + jnp.einsum("bhs,bhsd->bhd", w_end, kb)
        return (cmat, nvec, m_new), h

    state, out = lax.scan(step, state, (_chunks(q), _chunks(k), _chunks(v), _chunks(log_i), _chunks(log_f)))
    return _unchunk(out, dtype), state


def s5_discretize(a_re, a_im, log_dt, b_re, b_im, c_re, c_im):
    a_re = a_re.astype(jnp.float32)
    a_im = a_im.astype(jnp.float32)
    dt = jnp.exp(log_dt.astype(jnp.float32))[:, None]
    mag = jnp.exp(a_re * dt)
    lam_re = mag * jnp.cos(a_im * dt)
    lam_im = mag * jnp.sin(a_im * dt)
    den = a_re * a_re + a_im * a_im
    num_re, num_im = lam_re - 1.0, lam_im
    fr = (num_re * a_re + num_im * a_im) / den
    fi = (num_im * a_re - num_re * a_im) / den
    b_re = b_re.astype(jnp.float32)
    b_im = b_im.astype(jnp.float32)
    bb_re = fr[..., None] * b_re - fi[..., None] * b_im
    bb_im = fr[..., None] * b_im + fi[..., None] * b_re
    return dict(lam_re=lam_re, lam_im=lam_im, bb_re=bb_re, bb_im=bb_im,
                c_re=c_re.astype(jnp.float32), c_im=c_im.astype(jnp.float32))


def _complex_affine_combine(e1, e2):
    a1r, a1i, b1r, b1i = e1
    a2r, a2i, b2r, b2i = e2
    return (a1r * a2r - a1i * a2i, a1r * a2i + a1i * a2r,
            a2r * b1r - a2i * b1i + b2r, a2r * b1i + a2i * b1r + b2i)


def s5_scan(u, state, *, lam_re, lam_im, bb_re, bb_im, c_re, c_im):
    dtype = u.dtype
    b, l, _ = u.shape
    ug = jnp.swapaxes(u.astype(jnp.float32).reshape(b, l, S5_GROUPS, S5_GROUP), 0, 1)
    bu_re = jnp.einsum("lbgh,gph->lbgp", ug, bb_re)
    bu_im = jnp.einsum("lbgh,gph->lbgp", ug, bb_im)
    x0_re, x0_im = state
    bu_re = bu_re.at[0].add(lam_re * x0_re - lam_im * x0_im)
    bu_im = bu_im.at[0].add(lam_re * x0_im + lam_im * x0_re)
    a_re = jnp.broadcast_to(lam_re, (l, 1) + lam_re.shape)
    a_im = jnp.broadcast_to(lam_im, (l, 1) + lam_im.shape)
    _, _, x_re, x_im = lax.associative_scan(_complex_affine_combine, (a_re, a_im, bu_re, bu_im), axis=0)
    y = jnp.einsum("lbgp,ghp->blgh", x_re, c_re) - jnp.einsum("lbgp,ghp->blgh", x_im, c_im)
    return y.reshape(b, l, BR_WIDTH).astype(dtype), (x_re[-1], x_im[-1])


def bidirectional(scan_fwd, scan_bwd, ctx_fwd, lat_fwd, ctx_bwd, lat_bwd, state0):
    oc_f, st = scan_fwd(*ctx_fwd, state0)
    ox_f, _ = scan_fwd(*lat_fwd, st)
    rev = lambda ts: [jnp.flip(t, axis=1) for t in ts]
    oc_b, st = scan_bwd(*rev(ctx_bwd), state0)
    ox_b, _ = scan_bwd(*rev(lat_bwd), st)
    return oc_f + jnp.flip(oc_b, axis=1), ox_f + jnp.flip(ox_b, axis=1)


def grid_dwconv(t, w, bias, rows, cols):
    b, l, ch = t.shape
    img = t.reshape(b, rows, cols, ch)
    out = lax.conv_general_dilated(img, w[:, :, None, :].astype(t.dtype), (1, 1), "SAME",
                                   dimension_numbers=("NHWC", "HWIO", "NHWC"),
                                   feature_group_count=ch)
    return (out + bias).reshape(b, l, ch)


def gated_merge(branch_outs, gate_pre, w_branch, w_out):
    g = gate_pre.reshape(gate_pre.shape[:2] + (N_BRANCH, D_MODEL))
    y = jax.nn.sigmoid(g[:, :, 0]) * (branch_outs[0] @ w_branch[0])
    for j in range(1, N_BRANCH):
        y = y + jax.nn.sigmoid(g[:, :, j]) * (branch_outs[j] @ w_branch[j])
    return y @ w_out


def token_mixer(hc, hx, lp, lb, with_ctx):
    bsz = hx.shape[0]
    rows = hx.shape[1] // GRID_W
    cc = _split_cols(hc @ lp["w_in"])
    cx = _split_cols(hx @ lp["w_in"])
    zeros_s = jnp.zeros((bsz, N_HEADS, HEAD_DIM, HEAD_DIM), jnp.float32)

    def hgrn_in(cols, d):
        log_f, k = hgrn2_forget(cols[1 + d], lb[d])
        return (heads(jax.nn.silu(cols[0])), heads(k), heads(cols[3]), heads(log_f))
    raw_a = bidirectional(hgrn2_scan, hgrn2_scan, hgrn_in(cc, 0), hgrn_in(cx, 0),
                          hgrn_in(cc, 1), hgrn_in(cx, 1), zeros_s)

    log_gamma = jnp.log1p(-jnp.exp(lp["ret_decay"].astype(jnp.float32)))
    ret_in = lambda cols: (heads(cols[5]), heads(cols[6]) * HEAD_DIM ** -0.5, heads(cols[7]))
    raw_b = bidirectional(functools.partial(retention_scan, log_gamma=log_gamma[0]),
                          functools.partial(retention_scan, log_gamma=log_gamma[1]),
                          ret_in(cc), ret_in(cx), ret_in(cc), ret_in(cx), zeros_s)

    s5_fns = [functools.partial(s5_scan, **s5_discretize(
        lp["s5_a_re"][d], lp["s5_a_im"][d], lp["s5_log_dt"][d], lp["s5_b_re"][d],
        lp["s5_b_im"][d], lp["s5_c_re"][d], lp["s5_c_im"][d])) for d in (0, 1)]
    x0 = (jnp.zeros((bsz, S5_GROUPS, S5_STATE), jnp.float32),
          jnp.zeros((bsz, S5_GROUPS, S5_STATE), jnp.float32))
    raw_c = bidirectional(s5_fns[0], s5_fns[1], (cc[9],), (cx[9],), (cc[9],), (cx[9],), x0)

    def mlstm_in(cols, n_rows, n_cols):
        qk = jax.nn.silu(grid_dwconv(cols[10], lp["mlstm_conv_w"], lp["mlstm_conv_b"], n_rows, n_cols))
        q, k = jnp.split(qk, 2, axis=-1)
        g = (cols[13] + lp["mlstm_gate_b"].reshape(-1)).astype(jnp.float32)
        g = g.reshape(g.shape[:2] + (2, 2, N_HEADS))
        base = (heads(q), heads(k) * HEAD_DIM ** -0.5, heads(cols[11]))
        return [base + (g[:, :, d, 0], jax.nn.log_sigmoid(g[:, :, d, 1])) for d in (0, 1)]
    mc = mlstm_in(cc, 1, hc.shape[1])
    mx = mlstm_in(cx, rows, GRID_W)
    st0 = (zeros_s, jnp.zeros((bsz, N_HEADS, HEAD_DIM), jnp.float32),
           jnp.zeros((bsz, N_HEADS), jnp.float32))
    raw_d = bidirectional(mlstm_scan, mlstm_scan, mc[0], mx[0], mc[1], mx[1], st0)

    def finish(cols, s):
        oa = head_rmsnorm(raw_a[s], lp["hgrn_norm"]) * jax.nn.silu(cols[4])
        ob = head_rmsnorm(raw_b[s], lp["ret_norm"]) * jax.nn.silu(cols[8])
        yc = jax.nn.gelu(raw_c[s] + lp["s5_d"] * cols[9], approximate=False)
        oc = yc * jax.nn.sigmoid(yc @ lp["s5_glu_w"] + lp["s5_glu_b"])
        od = head_rmsnorm(raw_d[s], lp["mlstm_norm"]) * jax.nn.silu(cols[12])
        return gated_merge((oa, ob, oc, od), cols[14], lp["w_branch"], lp["w_out"])

    out_x = finish(cx, 1)
    out_c = finish(cc, 0) if with_ctx else None
    return out_c, out_x


def sq_relu_mlp(h, w1, w2):
    return jnp.square(jax.nn.relu(h @ w1)) @ w2


def trunk_layer(xc, xx, c, c_ctx, lp, lb, with_ctx):
    mod_x = jnp.split((jax.nn.silu(c) @ lp["w_mod"] + lp["b_mod"])[:, None, :], N_MOD, axis=-1)
    mod_c = jnp.split((jax.nn.silu(c_ctx)[None] @ lp["w_mod"] + lp["b_mod"])[:, None, :], N_MOD, axis=-1)
    hx = modulate(rmsnorm(xx, lp["norm_mix"]), mod_x[0], mod_x[1])
    hc = modulate(rmsnorm(xc, lp["norm_mix"]), mod_c[0], mod_c[1])
    mix_c, mix_x = token_mixer(hc, hx, lp, lb, with_ctx)
    xx = xx + mod_x[2] * mix_x
    xx = xx + mod_x[5] * sq_relu_mlp(modulate(rmsnorm(xx, lp["norm_mlp"]), mod_x[3], mod_x[4]),
                                     lp["w_ff1"], lp["w_ff2"])
    if with_ctx:
        xc = xc + mod_c[2] * mix_c
        xc = xc + mod_c[5] * sq_relu_mlp(modulate(rmsnorm(xc, lp["norm_mlp"]), mod_c[3], mod_c[4]),
                                         lp["w_ff1"], lp["w_ff2"])
    return xc, xx


def setup_inputs(seed: int = 0) -> dict:
    key = jax.random.key(seed)
    keys = iter(jax.random.split(key, 48))
    f32 = jnp.float32
    nrm = lambda shape, scale: scale * jax.random.normal(next(keys), shape, f32)
    L = DEPTH
    G, P, Hg = S5_GROUPS, S5_STATE, S5_GROUP
    x = nrm((BATCH, SEQ, D_MODEL), 1.0)
    c = nrm((BATCH, D_MODEL), 1.0)
    ctx = nrm((BATCH, CTX_LEN, D_MODEL), 1.0)
    c_ctx = nrm((D_MODEL,), 1.0)
    w_mod = nrm((L, D_MODEL, N_MOD * D_MODEL), 0.5 * D_MODEL ** -0.5)
    b_mod = nrm((L, N_MOD * D_MODEL), 0.02)
    norm_mix = 1.0 + nrm((L, D_MODEL), 0.02)
    norm_mlp = 1.0 + nrm((L, D_MODEL), 0.02)
    w_in = nrm((L, D_MODEL, IN_WIDTH), D_MODEL ** -0.5)
    hgrn_lb_logits = nrm((L, 2, BR_WIDTH), 0.5)
    hgrn_norm = 1.0 + nrm((L, BR_WIDTH), 0.02)
    ret_base = -(RET_DECAY_EXP0 + jnp.arange(N_HEADS, dtype=f32)) * math.log(2.0)
    ret_decay = ret_base + nrm((L, 2, N_HEADS), 0.05)
    ret_norm = 1.0 + nrm((L, BR_WIDTH), 0.02)
    s5_a_re = -0.5 * jnp.exp(nrm((L, 2, G, P), 0.05))
    s5_a_im = math.pi * jnp.arange(P, dtype=f32) + nrm((L, 2, G, P), 0.01)
    u = jax.random.uniform(next(keys), (L, 2, G), f32)
    s5_log_dt = math.log(S5_DT_MIN) + u * (math.log(S5_DT_MAX) - math.log(S5_DT_MIN))
    s5_b_re = nrm((L, 2, G, P, Hg), (2 * Hg) ** -0.5)
    s5_b_im = nrm((L, 2, G, P, Hg), (2 * Hg) ** -0.5)
    s5_c_re = nrm((L, 2, G, Hg, P), (2 * P) ** -0.5)
    s5_c_im = nrm((L, 2, G, Hg, P), (2 * P) ** -0.5)
    s5_d = nrm((L, BR_WIDTH), 0.5)
    s5_glu_w = nrm((L, BR_WIDTH, BR_WIDTH), BR_WIDTH ** -0.5)
    s5_glu_b = nrm((L, BR_WIDTH), 0.02)
    mlstm_conv_w = nrm((L, CONV_K, CONV_K, 2 * BR_WIDTH), 1.0 / CONV_K)
    mlstm_conv_b = nrm((L, 2 * BR_WIDTH), 0.02)
    i_bias = nrm((L, 2, N_HEADS), 0.1)
    f_bias = jnp.linspace(MLSTM_F_BIAS_LO, MLSTM_F_BIAS_HI, N_HEADS, dtype=f32) + nrm((L, 2, N_HEADS), 0.1)
    mlstm_gate_b = jnp.stack([i_bias, f_bias], axis=2)
    mlstm_norm = 1.0 + nrm((L, BR_WIDTH), 0.02)
    w_branch = nrm((L, N_BRANCH, BR_WIDTH, D_MODEL), BR_WIDTH ** -0.5)
    w_out = nrm((L, D_MODEL, D_MODEL), D_MODEL ** -0.5)
    w_ff1 = nrm((L, D_MODEL, D_FF), D_MODEL ** -0.5)
    w_ff2 = nrm((L, D_FF, D_MODEL), D_FF ** -0.5)
    final_norm = 1.0 + nrm((D_MODEL,), 0.02)
    return {"x": x, "c": c, "ctx": ctx, "c_ctx": c_ctx, "w_mod": w_mod, "b_mod": b_mod,
            "norm_mix": norm_mix, "norm_mlp": norm_mlp, "w_in": w_in,
            "hgrn_lb_logits": hgrn_lb_logits, "hgrn_norm": hgrn_norm,
            "ret_decay": ret_decay, "ret_norm": ret_norm,
            "s5_a_re": s5_a_re, "s5_a_im": s5_a_im, "s5_log_dt": s5_log_dt,
            "s5_b_re": s5_b_re, "s5_b_im": s5_b_im, "s5_c_re": s5_c_re, "s5_c_im": s5_c_im,
            "s5_d": s5_d, "s5_glu_w": s5_glu_w, "s5_glu_b": s5_glu_b,
            "mlstm_conv_w": mlstm_conv_w, "mlstm_conv_b": mlstm_conv_b,
            "mlstm_gate_b": mlstm_gate_b, "mlstm_norm": mlstm_norm,
            "w_branch": w_branch, "w_out": w_out, "w_ff1": w_ff1, "w_ff2": w_ff2,
            "final_norm": final_norm}


def reference(x, c, ctx, c_ctx, w_mod, b_mod, norm_mix, norm_mlp, w_in, hgrn_lb_logits, hgrn_norm,
              ret_decay, ret_norm, s5_a_re, s5_a_im, s5_log_dt, s5_b_re, s5_b_im, s5_c_re, s5_c_im,
              s5_d, s5_glu_w, s5_glu_b, mlstm_conv_w, mlstm_conv_b, mlstm_gate_b, mlstm_norm,
              w_branch, w_out, w_ff1, w_ff2, final_norm):
    p_lb = jax.nn.softmax(hgrn_lb_logits.astype(jnp.float32), axis=0)
    lower_bounds = jnp.cumsum(p_lb, axis=0) - p_lb[0]
    hc, hx = ctx, x
    for l in range(DEPTH):
        lp = dict(w_mod=w_mod[l], b_mod=b_mod[l], norm_mix=norm_mix[l], norm_mlp=norm_mlp[l],
                  w_in=w_in[l], hgrn_norm=hgrn_norm[l], ret_decay=ret_decay[l], ret_norm=ret_norm[l],
                  s5_a_re=s5_a_re[l], s5_a_im=s5_a_im[l], s5_log_dt=s5_log_dt[l],
                  s5_b_re=s5_b_re[l], s5_b_im=s5_b_im[l], s5_c_re=s5_c_re[l], s5_c_im=s5_c_im[l],
                  s5_d=s5_d[l], s5_glu_w=s5_glu_w[l], s5_glu_b=s5_glu_b[l],
                  mlstm_conv_w=mlstm_conv_w[l], mlstm_conv_b=mlstm_conv_b[l],
                  mlstm_gate_b=mlstm_gate_b[l], mlstm_norm=mlstm_norm[l],
                  w_branch=w_branch[l], w_out=w_out[l], w_ff1=w_ff1[l], w_ff2=w_ff2[l])
        hc, hx = trunk_layer(hc, hx, c, c_ctx, lp, lower_bounds[l], l < DEPTH - 1)
    return rmsnorm(hx, final_norm)
```

```cpp
#include <hip/hip_runtime.h>
#include <hip/hip_cooperative_groups.h>
#include <cstdio>
namespace cg = cooperative_groups;

#define LAS __attribute__((address_space(3)))
typedef unsigned short bf16_t;
typedef short bf16x8 __attribute__((ext_vector_type(8)));
typedef float f32x4 __attribute__((ext_vector_type(4)));
typedef unsigned u32x4 __attribute__((ext_vector_type(4)));
typedef unsigned u32x2 __attribute__((ext_vector_type(2)));

constexpr int DM = 2048, TL = 16384, TC = 1024, TT = 17408, NIN = 15376, NINP = 15616, NMOD = 12288;
constexpr int C_HQ = 0, C_HF = 512, C_HV = 1536, C_HG = 2048, C_RQ = 2560, C_RK = 3072, C_RV = 3584, C_RG = 4096, C_SU = 4608,
              C_MQK = 5120, C_MV = 6144, C_MZ = 6656, C_MG = 7168, C_GATE = 7184;
constexpr size_t al256(size_t x) { return (x + 255) & ~(size_t)255; }
constexpr size_t OFF_WIN = 0;
constexpr size_t OFF_WFF1 = OFF_WIN + al256((size_t)NINP * 2048 * 2);
constexpr size_t OFF_WFF2 = OFF_WFF1 + al256((size_t)8192 * 2048 * 2);
constexpr size_t OFF_WOUT = OFF_WFF2 + al256((size_t)8192 * 2048 * 2);
constexpr size_t OFF_WBR = OFF_WOUT + al256((size_t)2048 * 2048 * 2);
constexpr size_t OFF_WGLU = OFF_WBR + al256((size_t)4 * 2048 * 512 * 2);
constexpr size_t OFF_MOD = OFF_WGLU + al256((size_t)512 * 512 * 2);
constexpr size_t OFF_ACT = OFF_MOD + al256((size_t)2 * 5 * NMOD * 4);
constexpr size_t OFF_COLS = OFF_ACT + al256((size_t)TT * 2048 * 2);
constexpr size_t OFF_O = OFF_COLS + al256((size_t)TT * NIN * 2);
constexpr size_t OFF_YC = OFF_O + al256((size_t)TT * 2048 * 2);
constexpr size_t OFF_RAW = OFF_YC + al256((size_t)TT * 512 * 2);
constexpr size_t OFF_XC = OFF_RAW + al256((size_t)8 * TT * 512 * 2);
constexpr size_t WS_NEED = OFF_XC + al256((size_t)TC * 2048 * 4);
constexpr size_t OFF_BAR = WS_NEED;
constexpr size_t WS_TOTAL = WS_NEED + 16384 + 262144;
constexpr size_t OFF_W8 = OFF_WIN + (size_t)7424 * 2048 * 2;
constexpr size_t OFF_H8 = OFF_O;
constexpr size_t OFF_SC = WS_NEED + 16384;
constexpr size_t OFF_QK = OFF_O;
constexpr size_t OFF_U = OFF_COLS;

constexpr int kPhaseLds = 139264;
constexpr int kDynLds = kPhaseLds + 16;

struct Params {
  const float* in[32];
  float* out;
  unsigned char* ws;
};

__device__ __forceinline__ float bf2f(unsigned b) { return __uint_as_float(b << 16); }
__device__ __forceinline__ float bflo(unsigned w) { return __uint_as_float(w << 16); }
__device__ __forceinline__ float bfhi(unsigned w) { return __uint_as_float(w & 0xffff0000u); }
__device__ __forceinline__ bf16_t f2bf(float f) { unsigned u = __float_as_uint(f); u += 0x7FFFu + ((u >> 16) & 1u); return (bf16_t)(u >> 16); }
typedef __bf16 bf16v2_t __attribute__((ext_vector_type(2)));
typedef float f32x2_t __attribute__((ext_vector_type(2)));
__device__ __forceinline__ unsigned cvt_pk_bf16(float lo, float hi) { f32x2_t v = {lo, hi}; bf16v2_t r = __builtin_convertvector(v, bf16v2_t); return __builtin_bit_cast(unsigned, r); }
__device__ __forceinline__ bf16_t f2bf_hw(float f) { return (bf16_t)(cvt_pk_bf16(f, f) & 0xffffu); }
__device__ __forceinline__ float sigm(float x) { return 1.0f / (1.0f + __expf(-x)); }
__device__ __forceinline__ float siluf(float x) { return x / (1.0f + __expf(-x)); }
__device__ __forceinline__ float wave_sum(float v) {
#pragma unroll
  for (int m = 32; m >= 1; m >>= 1) v += __shfl_xor(v, m);
  return v;
}
template <int CTRL, int ROWMASK> __device__ __forceinline__ float dpp_mov(float identity, float v) {
  return __builtin_bit_cast(float, __builtin_amdgcn_update_dpp(__builtin_bit_cast(int, identity), __builtin_bit_cast(int, v), CTRL, ROWMASK, 0xF, false));
}
__device__ __forceinline__ float wave_scan_add(float v) {
  v += dpp_mov<0x111, 0xF>(0.f, v); v += dpp_mov<0x112, 0xF>(0.f, v); v += dpp_mov<0x114, 0xF>(0.f, v); v += dpp_mov<0x118, 0xF>(0.f, v);
  v += dpp_mov<0x142, 0xA>(0.f, v); v += dpp_mov<0x143, 0xC>(0.f, v); return v;
}
__device__ __forceinline__ float wave_scan_max(float v) {
  const float ninf = -__builtin_inff();
  v = fmaxf(v, dpp_mov<0x111, 0xF>(ninf, v)); v = fmaxf(v, dpp_mov<0x112, 0xF>(ninf, v)); v = fmaxf(v, dpp_mov<0x114, 0xF>(ninf, v)); v = fmaxf(v, dpp_mov<0x118, 0xF>(ninf, v));
  v = fmaxf(v, dpp_mov<0x142, 0xA>(ninf, v)); v = fmaxf(v, dpp_mov<0x143, 0xC>(ninf, v)); return v;
}
__device__ __forceinline__ int otid() { int t = threadIdx.x; asm volatile("" : "+v"(t)); return t; }
__device__ __forceinline__ int seqrow(int s, int b, int dir) {
  if (s < 256) { const int t = dir ? 255 - s : s; return TL + b * 256 + t; }
  int t = s - 256; t = dir ? 4095 - t : t; return b * 4096 + t;
}

namespace pg8 {
constexpr int BM = 256, BK = 64, HALF = 128, HTB = HALF * BK * 2, NXCD = 8, WGM = 4;
__device__ __forceinline__ int lds_byte(int r, int c) { const int st = (r >> 4) * 2 + (c >> 5), rr = r & 15, cc = c & 31, ob = rr * 64 + cc * 2; return st * 1024 + (ob ^ (((ob >> 9) & 1) << 5)); }
__device__ __forceinline__ void stage_rc(int b, int& R, int& C) { const int st = b / 1024, sb = b % 1024, swz = sb ^ (((sb >> 9) & 1) << 5); R = (st >> 1) * 16 + swz / 64; C = (st & 1) * 32 + (swz % 64) / 2; }
__device__ __forceinline__ int perm32(int rho) { const int n = rho >> 4, i = rho & 15; return 8 * (i >> 2) + 4 * n + (i & 3); }
struct Unit { int pm, pn, kz; };
}

enum { E_COLS = 0, E_GLU = 1, E_MERGE = 2, E_RES = 3, E_RELU2 = 4, E_GATE8 = 5 };
typedef int i32x4 __attribute__((ext_vector_type(4)));
struct GemmDesc {
  const bf16_t* A; const bf16_t* Bt; int lda, ldb, M, N, K, nkz; size_t kzA, kzB;
  int epi;
  bf16_t* obf; int ldo; int ncols;
  const bf16_t* gsrc; const float* bias;
  const float* xin_lat; const float* xin_ctx; float* xout_lat; float* xout_ctx; const float* mod; int moff;
  const float* rowscale; const float* colmax;
};

struct TileOrder {
  int nM, nN, nwg, G, c, nkz;
  __device__ bool next(int i, pg8::Unit& u) const {
    using namespace pg8;
    const int r = (nkz == 4) ? (i >> 2) : i; u.kz = (nkz == 4) ? (i & 3) : 0;
    const long L = (long)r * G + c; if (L >= nwg) return false;
    int wgid = (int)L; { const int q = nwg / NXCD, rr = nwg % NXCD, xcd = wgid % NXCD, off = wgid / NXCD; wgid = (xcd < rr ? xcd * (q + 1) : rr * (q + 1) + (xcd - rr) * q) + off; }
    const int nig = WGM * nN, gid = wgid / nig, fm = gid * WGM, gsz = (nM - fm) < WGM ? (nM - fm) : WGM;
    u.pm = fm + ((wgid % nig) % gsz); u.pn = (wgid % nig) / gsz; return true;
  }
};

__device__ __forceinline__ bool gemm_epilogue(const GemmDesc& g, f32x4 (&acc)[2][2][4][2], const pg8::Unit& u, int wr, int wc, int fr, int fq) {
  const int row0 = u.pm * 256 + wr * 64 + fr;
  const int col0 = u.pn * 256 + wc * 32 + 8 * fq;
  if (g.epi == E_COLS || g.epi == E_RELU2) {
    const bool relu2 = (g.epi == E_RELU2);
    const bool dosilu = (g.epi == E_COLS) && (u.pn < 2);
#pragma unroll
    for (int ai = 0; ai < 2; ++ai)
#pragma unroll
      for (int m = 0; m < 4; ++m) {
        bf16_t* rowp = g.obf + (size_t)(row0 + ai * 128 + m * 16) * g.ldo + col0;
#pragma unroll
        for (int bj = 0; bj < 2; ++bj) {
          f32x4 v0 = acc[ai][bj][m][0], v1 = acc[ai][bj][m][1];
          if (relu2) {
#pragma unroll
            for (int j = 0; j < 4; ++j) { float a = fmaxf(v0[j], 0.f), b = fmaxf(v1[j], 0.f); v0[j] = a * a; v1[j] = b * b; }
          }
          if (dosilu) {
#pragma unroll
            for (int j = 0; j < 4; ++j) { v0[j] = v0[j] * __builtin_amdgcn_rcpf(1.0f + __expf(-v0[j])); v1[j] = v1[j] * __builtin_amdgcn_rcpf(1.0f + __expf(-v1[j])); }
          }
          u32x4 w; w.x = cvt_pk_bf16(v0[0], v0[1]); w.y = cvt_pk_bf16(v0[2], v0[3]); w.z = cvt_pk_bf16(v1[0], v1[1]); w.w = cvt_pk_bf16(v1[2], v1[3]);
          if (col0 + bj * 128 < g.ncols) *(u32x4*)(rowp + bj * 128) = w;
        }
      }
    return false;
  }
  if (g.epi == E_GATE8) {
#pragma unroll
    for (int bj = 0; bj < 2; ++bj) {
      const f32x4 w0 = *(const f32x4*)(g.colmax + col0 + bj * 128) * (1.0f / 127.0f), w1 = *(const f32x4*)(g.colmax + col0 + bj * 128 + 4) * (1.0f / 127.0f);
#pragma unroll
      for (int ai = 0; ai < 2; ++ai)
#pragma unroll
        for (int m = 0; m < 4; ++m) {
          const size_t row = (size_t)(row0 + ai * 128 + m * 16);
          const float rs = g.rowscale[row];
          const i32x4 a0 = __builtin_bit_cast(i32x4, acc[ai][bj][m][0]), a1 = __builtin_bit_cast(i32x4, acc[ai][bj][m][1]);
          float e[8];
#pragma unroll
          for (int j = 0; j < 4; ++j) { e[j] = __expf(-fmaxf((float)a0[j] * rs * w0[j], -80.f)); e[4 + j] = __expf(-fmaxf((float)a1[j] * rs * w1[j], -80.f)); }
          u32x4 w;
          w.x = cvt_pk_bf16(e[0], e[1]); w.y = cvt_pk_bf16(e[2], e[3]); w.z = cvt_pk_bf16(e[4], e[5]); w.w = cvt_pk_bf16(e[6], e[7]);
          *(u32x4*)(g.obf + row * g.ldo + col0 + bj * 128) = w;
        }
    }
    return false;
  }
  if (g.epi == E_GLU) {
#pragma unroll
    for (int bj = 0; bj < 2; ++bj) {
      const f32x4 b0 = *(const f32x4*)(g.bias + col0 + bj * 128), b1 = *(const f32x4*)(g.bias + col0 + bj * 128 + 4);
#pragma unroll
      for (int ai = 0; ai < 2; ++ai)
#pragma unroll
        for (int m = 0; m < 4; ++m) {
          const size_t row = (size_t)(row0 + ai * 128 + m * 16);
          const u32x4 y = *(const u32x4*)(g.gsrc + row * 512 + col0 + bj * 128);
          const f32x4 v0 = acc[ai][bj][m][0] + b0, v1 = acc[ai][bj][m][1] + b1;
          u32x4 w;
          w.x = cvt_pk_bf16(bflo(y.x) * sigm(v0[0]), bfhi(y.x) * sigm(v0[1]));
          w.y = cvt_pk_bf16(bflo(y.y) * sigm(v0[2]), bfhi(y.y) * sigm(v0[3]));
          w.z = cvt_pk_bf16(bflo(y.z) * sigm(v1[0]), bfhi(y.z) * sigm(v1[1]));
          w.w = cvt_pk_bf16(bflo(y.w) * sigm(v1[2]), bfhi(y.w) * sigm(v1[3]));
          *(u32x4*)(g.obf + row * g.ldo + col0 + bj * 128) = w;
        }
    }
    return false;
  }
  if (g.epi == E_MERGE) {
    const int kz = u.kz;
    const bool lastz = (kz == 3);
#pragma unroll
    for (int ai = 0; ai < 2; ++ai)
#pragma unroll
      for (int m = 0; m < 4; ++m) {
        const size_t row = (size_t)(row0 + ai * 128 + m * 16);
        const bf16_t* gp = g.gsrc + row * NIN + C_GATE + kz * 2048 + col0;
#pragma unroll
        for (int bj = 0; bj < 2; ++bj) {
          unsigned wout[4];
#pragma unroll
          for (int n = 0; n < 2; ++n) {
            const u32x2 ga = *(const u32x2*)(gp + bj * 128 + n * 4);
            const float ea[4] = {bflo(ga.x), bfhi(ga.x), bflo(ga.y), bfhi(ga.y)};
            f32x4 v = acc[ai][bj][m][n];
            if (!lastz) {
              const u32x2 gb = *(const u32x2*)(gp + 2048 + bj * 128 + n * 4);
              const float eb[4] = {bflo(gb.x), bfhi(gb.x), bflo(gb.y), bfhi(gb.y)};
#pragma unroll
              for (int j = 0; j < 4; ++j) v[j] *= (1.0f + eb[j]) * __builtin_amdgcn_rcpf(1.0f + ea[j]);
              acc[ai][bj][m][n] = v;
            } else {
#pragma unroll
              for (int j = 0; j < 4; ++j) v[j] *= __builtin_amdgcn_rcpf(1.0f + ea[j]);
              wout[n * 2] = cvt_pk_bf16(v[0], v[1]); wout[n * 2 + 1] = cvt_pk_bf16(v[2], v[3]);
            }
          }
          if (lastz) { u32x4 w; w.x = wout[0]; w.y = wout[1]; w.z = wout[2]; w.w = wout[3]; *(u32x4*)(g.obf + row * g.ldo + col0 + bj * 128) = w; }
        }
        __builtin_amdgcn_sched_barrier(0);
      }
    return !lastz;
  }
  {
    const bool isctx = (u.pm >= 64);
    const float* xin = isctx ? g.xin_ctx - (size_t)TL * 2048 : g.xin_lat;
    float* xout = isctx ? g.xout_ctx - (size_t)TL * 2048 : g.xout_lat;
    const float* mp = g.mod + (size_t)(isctx ? 4 : (u.pm >> 4)) * NMOD + g.moff + col0;
#pragma unroll
    for (int bj = 0; bj < 2; ++bj) {
      const f32x4 m0 = *(const f32x4*)(mp + bj * 128), m1 = *(const f32x4*)(mp + bj * 128 + 4);
#pragma unroll
      for (int ai = 0; ai < 2; ++ai)
#pragma unroll
        for (int m = 0; m < 4; ++m) {
          const size_t off = (size_t)(row0 + ai * 128 + m * 16) * 2048 + col0 + bj * 128;
          const f32x4 x0 = *(const f32x4*)(xin + off), x1 = *(const f32x4*)(xin + off + 4);
          *(f32x4*)(xout + off) = x0 + m0 * acc[ai][bj][m][0];
          *(f32x4*)(xout + off + 4) = x1 + m1 * acc[ai][bj][m][1];
        }
    }
    return false;
  }
}

template <bool I8 = false>
__device__ __forceinline__ void gemm_phase(LAS unsigned char* lds, const GemmDesc& g) {
  using namespace pg8;
  const int tid = otid(), wid = __builtin_amdgcn_readfirstlane(tid >> 6), lane = tid & 63, wr = wid >> 2, wc = wid & 3, fr = lane & 15, fq = lane >> 4;
  const int K = g.K, nt = K / BK;
  TileOrder S; S.nM = g.M / BM; S.nN = g.N / BM; S.nwg = S.nM * S.nN; S.G = (int)gridDim.x; S.c = (int)blockIdx.x; S.nkz = g.nkz;
  unsigned voffA[2], voffB[2];
#pragma unroll
  for (int i = 0; i < 2; ++i) { int R, C; stage_rc(tid * 16 + i * 8192, R, C); const int Rb = (R & ~31) + perm32(R & 31);
    voffA[i] = (unsigned)(R * g.lda + C) * 2u; voffB[i] = (unsigned)(Rb * g.ldb + C) * 2u; }
  const size_t kstep = (size_t)(BK * 2);
  const size_t hstepA = (size_t)HALF * g.lda * 2, hstepB = (size_t)HALF * g.ldb * 2;
  const size_t tstepA = 2 * hstepA, tstepB = 2 * hstepB;
  const unsigned ldsw = (unsigned)wid * 1024u;
  const int aoff = lds_byte(wr * 64 + fr, fq * 8), boff = lds_byte(wc * 32 + fr, fq * 8);
#define PG8_SA(b, h) (((b) * 2 + (h)) * HTB)
#define PG8_SB(b, h) ((4 + (b) * 2 + (h)) * HTB)
#define PG8_STAGE(bufoff, gbase, voff) do { _Pragma("unroll") for (int _i = 0; _i < 2; ++_i) \
        __builtin_amdgcn_global_load_lds((const unsigned*)((const char*)(gbase) + (voff)[_i]), (LAS unsigned*)(lds + (bufoff) + ldsw + _i * 8192), 16, 0, 0); } while (0)
#define PG8_LDA(dst, b, h) do { _Pragma("unroll") for (int m = 0; m < 4; ++m) _Pragma("unroll") for (int k = 0; k < 2; ++k) dst[m][k] = *(const LAS bf16x8*)(lds + PG8_SA(b, h) + aoff + m * 2048 + k * 1024); } while (0)
#define PG8_LDB(dst, b, h) do { _Pragma("unroll") for (int n = 0; n < 2; ++n) _Pragma("unroll") for (int k = 0; k < 2; ++k) dst[n][k] = *(const LAS bf16x8*)(lds + PG8_SB(b, h) + boff + n * 2048 + k * 1024); } while (0)
#define PG8_MMA(ai, bj, At, Bt) do { __builtin_amdgcn_s_setprio(1); _Pragma("unroll") for (int m = 0; m < 4; ++m) _Pragma("unroll") for (int n = 0; n < 2; ++n) _Pragma("unroll") for (int k = 0; k < 2; ++k) \
        { if constexpr (I8) acc[ai][bj][m][n] = __builtin_bit_cast(f32x4, __builtin_amdgcn_mfma_i32_16x16x64_i8(__builtin_bit_cast(i32x4, Bt[n][k]), __builtin_bit_cast(i32x4, At[m][k]), __builtin_bit_cast(i32x4, acc[ai][bj][m][n]), 0, 0, 0)); \
          else acc[ai][bj][m][n] = __builtin_amdgcn_mfma_f32_16x16x32_bf16(Bt[n][k], At[m][k], acc[ai][bj][m][n], 0, 0, 0); } __builtin_amdgcn_s_setprio(0); } while (0)
#define PG8_WAIT_V(n) asm volatile("s_waitcnt vmcnt(" #n ")" ::: "memory")
#define PG8_WAIT_L(n) asm volatile("s_waitcnt lgkmcnt(" #n ")" ::: "memory")
#define PG8_BAR __builtin_amdgcn_s_barrier()
#define PG8_SCHED __builtin_amdgcn_sched_barrier(0)
  Unit cur, nxt; int ui = 0;
  if (!S.next(0, cur)) return;
  f32x4 acc[2][2][4][2];
#pragma unroll
  for (int a = 0; a < 2; ++a)
#pragma unroll
    for (int b = 0; b < 2; ++b)
#pragma unroll
      for (int m = 0; m < 4; ++m)
#pragma unroll
        for (int n = 0; n < 2; ++n) acc[a][b][m][n] = (f32x4){0.f, 0.f, 0.f, 0.f};
  bf16x8 At[4][2], B0[2][2], B1[2][2];
  const char* cA = (const char*)g.A + (size_t)cur.pm * tstepA + (size_t)cur.kz * g.kzA;
  const char* cB = (const char*)g.Bt + (size_t)cur.pn * tstepB + (size_t)cur.kz * g.kzB;
  PG8_STAGE(PG8_SB(0, 0), cB, voffB); PG8_STAGE(PG8_SA(0, 0), cA, voffA); PG8_STAGE(PG8_SB(0, 1), cB + hstepB, voffB); PG8_STAGE(PG8_SA(0, 1), cA + hstepA, voffA);
  if (wr == 1) PG8_BAR;
  PG8_WAIT_V(4); PG8_BAR;
  PG8_STAGE(PG8_SB(1, 0), cB + kstep, voffB); PG8_STAGE(PG8_SA(1, 0), cA + kstep, voffA); PG8_STAGE(PG8_SB(1, 1), cB + hstepB + kstep, voffB);
  PG8_WAIT_V(6); PG8_BAR;
  for (;;) {
    const bool has_next = S.next(ui + 1, nxt);
    const char* nA = has_next ? (const char*)g.A + (size_t)nxt.pm * tstepA + (size_t)nxt.kz * g.kzA : cA;
    const char* nB = has_next ? (const char*)g.Bt + (size_t)nxt.pn * tstepB + (size_t)nxt.kz * g.kzB : cB;
    for (int t = 0; t < nt; t += 2) {
      const bool last = (t == nt - 2);
      const char* a1 = cA + (size_t)(t + 1) * kstep;
      const char* a2 = last ? nA : cA + (size_t)(t + 2) * kstep; const char* b2 = last ? nB : cB + (size_t)(t + 2) * kstep;
      const char* a3 = a2 + kstep; const char* b3 = b2 + kstep;
      PG8_LDB(B0, 0, 0); PG8_SCHED; PG8_LDA(At, 0, 0); PG8_STAGE(PG8_SA(1, 1), a1 + hstepA, voffA);
      PG8_WAIT_L(8); PG8_BAR; PG8_WAIT_L(0); PG8_MMA(0, 0, At, B0); PG8_BAR; PG8_SCHED;
      PG8_LDB(B1, 0, 1); PG8_STAGE(PG8_SB(0, 0), b2, voffB);
      PG8_BAR; PG8_WAIT_L(0); PG8_MMA(0, 1, At, B1); PG8_BAR;
      PG8_LDA(At, 0, 1); PG8_STAGE(PG8_SA(0, 0), a2, voffA);
      PG8_BAR; PG8_WAIT_L(0); PG8_MMA(1, 0, At, B0); PG8_BAR; PG8_SCHED;
      PG8_STAGE(PG8_SB(0, 1), b2 + hstepB, voffB);
      PG8_WAIT_V(6); PG8_BAR; PG8_MMA(1, 1, At, B1); PG8_BAR;
      PG8_LDB(B0, 1, 0); PG8_SCHED; PG8_LDA(At, 1, 0); PG8_STAGE(PG8_SA(0, 1), a2 + hstepA, voffA);
      PG8_WAIT_L(8); PG8_BAR; PG8_WAIT_L(0); PG8_MMA(0, 0, At, B0); PG8_BAR; PG8_SCHED;
      PG8_LDB(B1, 1, 1); PG8_STAGE(PG8_SB(1, 0), b3, voffB);
      PG8_BAR; PG8_WAIT_L(0); PG8_MMA(0, 1, At, B1); PG8_BAR;
      PG8_LDA(At, 1, 1); PG8_STAGE(PG8_SA(1, 0), a3, voffA);
      PG8_BAR; PG8_WAIT_L(0); PG8_MMA(1, 0, At, B0); PG8_BAR; PG8_SCHED;
      PG8_STAGE(PG8_SB(1, 1), b3 + hstepB, voffB);
      PG8_WAIT_V(6); PG8_BAR; PG8_MMA(1, 1, At, B1); PG8_BAR;
    }
    const bool keep = gemm_epilogue(g, acc, cur, wr, wc, fr, fq);
    if (!has_next) break;
    if (!keep) {
#pragma unroll
      for (int a = 0; a < 2; ++a)
#pragma unroll
        for (int b = 0; b < 2; ++b)
#pragma unroll
          for (int m = 0; m < 4; ++m)
#pragma unroll
            for (int n = 0; n < 2; ++n) acc[a][b][m][n] = (f32x4){0.f, 0.f, 0.f, 0.f};
    }
    cur = nxt; cA = nA; cB = nB; ++ui;
  }
  PG8_WAIT_V(0);
  if (wr == 0) PG8_BAR;
  PG8_BAR;
#undef PG8_SA
#undef PG8_SB
#undef PG8_STAGE
#undef PG8_LDA
#undef PG8_LDB
#undef PG8_MMA
#undef PG8_WAIT_V
#undef PG8_WAIT_L
#undef PG8_BAR
#undef PG8_SCHED
}

__device__ __forceinline__ void phase_mod(const Params& p, unsigned char* smem, int l0, int l1, int first_blk_256) {
  const int first_blk = (gridDim.x == 256u) ? first_blk_256 : 0;
  if ((int)blockIdx.x < first_blk) return;
  float* sv = (float*)smem;
  float* red = sv + 5 * 2048;
  const int tid = otid();
  const float* c = p.in[1]; const float* cctx = p.in[3];
  for (int i = tid; i < 5 * 2048; i += 512) { const int m = i >> 11, k = i & 2047; const float v = m < 4 ? c[m * 2048 + k] : cctx[k]; sv[i] = v / (1.0f + expf(-v)); }
  __syncthreads();
  float* mod = (float*)(p.ws + OFF_MOD);
  for (int item = l0 * 96 + (int)blockIdx.x - first_blk; item < l1 * 96; item += (int)gridDim.x - first_blk) {
    const int l = item / 96, cb = (item % 96) * 128, kg = tid >> 5, c4 = (tid & 31) * 4;
    const float* w = p.in[4] + (size_t)l * 2048 * NMOD + cb + c4;
    f32x4 a0 = (f32x4){0.f, 0.f, 0.f, 0.f}, a1 = a0, a2 = a0, a3 = a0, a4 = a0;
#pragma unroll 16
    for (int k = kg * 128; k < kg * 128 + 128; ++k) {
      const f32x4 wv = *(const f32x4*)(w + (size_t)k * NMOD);
      a0 += sv[k] * wv; a1 += sv[2048 + k] * wv; a2 += sv[4096 + k] * wv; a3 += sv[6144 + k] * wv; a4 += sv[8192 + k] * wv;
    }
    *(f32x4*)(red + (kg * 5 + 0) * 128 + c4) = a0; *(f32x4*)(red + (kg * 5 + 1) * 128 + c4) = a1; *(f32x4*)(red + (kg * 5 + 2) * 128 + c4) = a2;
    *(f32x4*)(red + (kg * 5 + 3) * 128 + c4) = a3; *(f32x4*)(red + (kg * 5 + 4) * 128 + c4) = a4;
    __syncthreads();
    for (int o = tid; o < 5 * 128; o += 512) {
      const int m = o >> 7, col = o & 127;
      float sum = p.in[5][l * NMOD + cb + col];
#pragma unroll
      for (int g2 = 0; g2 < 16; ++g2) sum += red[(g2 * 5 + m) * 128 + col];
      mod[(size_t)(l * 5 + m) * NMOD + cb + col] = sum;
    }
    __syncthreads();
  }
}

__device__ __forceinline__ void phase_colmax(const Params& p, int l, unsigned char* smem, int first_blk_256) {
  const int first_blk = (gridDim.x == 256u) ? first_blk_256 : 0;
  if ((int)blockIdx.x < first_blk) return;
  float* red = (float*)smem;
  float* colmax = (float*)(p.ws + OFF_SC) + TT;
  const int tid = otid(), kg = tid >> 6, col = tid & 63;
  for (int item = (int)blockIdx.x - first_blk; item < 128; item += (int)gridDim.x - first_blk) {
    const float* w = p.in[8] + (size_t)l * 2048 * NIN + C_GATE + item * 64 + col;
    float m = 0.f;
#pragma unroll 16
    for (int k = kg * 256; k < kg * 256 + 256; ++k) m = fmaxf(m, fabsf(w[(size_t)k * NIN]));
    red[kg * 64 + col] = m;
    __syncthreads();
    if (tid < 64) { float mm = red[tid];
#pragma unroll
      for (int g2 = 1; g2 < 8; ++g2) mm = fmaxf(mm, red[g2 * 64 + tid]);
      colmax[item * 64 + tid] = fmaxf(mm, 1e-30f); }
    __syncthreads();
  }
}

struct CvtTile { const float* src; bf16_t* dst; int K, N, k0, n0, is8; };
__device__ __forceinline__ CvtTile cvt_lookup(const Params& p, int l, int t) {
  constexpr int T_IN = 32 * (NINP / 64), T_FF = 4096, T_OUT = 1024, T_BR = 256;
  CvtTile c; int r = t; c.is8 = 0;
  constexpr int T_INB = 32 * (7424 / 64);
  if (r < T_INB) { c.src = p.in[8] + (size_t)l * 2048 * NIN; c.K = 2048; c.N = NIN; c.dst = (bf16_t*)(p.ws + OFF_WIN); }
  else if (r < T_IN) { r -= T_INB; c.is8 = 1; c.src = p.in[8] + (size_t)l * 2048 * NIN + C_GATE; c.K = 2048; c.N = NIN; c.dst = (bf16_t*)(p.ws + OFF_W8); }
  else if ((r -= T_IN) < T_FF) { c.src = p.in[29] + (size_t)l * 2048 * 8192; c.K = 2048; c.N = 8192; c.dst = (bf16_t*)(p.ws + OFF_WFF1); }
  else if ((r -= T_FF) < T_FF) { c.src = p.in[30] + (size_t)l * 8192 * 2048; c.K = 8192; c.N = 2048; c.dst = (bf16_t*)(p.ws + OFF_WFF2); }
  else if ((r -= T_FF) < T_OUT) { c.src = p.in[28] + (size_t)l * 2048 * 2048; c.K = 2048; c.N = 2048; c.dst = (bf16_t*)(p.ws + OFF_WOUT); }
  else if ((r -= T_OUT) < 4 * T_BR) { const int j = r / T_BR; r -= j * T_BR; c.src = p.in[27] + (size_t)(l * 4 + j) * 512 * 2048; c.K = 512; c.N = 2048; c.dst = (bf16_t*)(p.ws + OFF_WBR) + (size_t)j * 2048 * 512; }
  else { r -= 4 * T_BR; c.src = p.in[21] + (size_t)l * 512 * 512; c.K = 512; c.N = 512; c.dst = (bf16_t*)(p.ws + OFF_WGLU); }
  const int nkt = c.K >> 6; c.k0 = (r % nkt) * 64; c.n0 = (r / nkt) * 64;
  return c;
}
constexpr int CVT_IN = 32 * (NINP / 64), CVT_FF2_LO = CVT_IN + 4096, CVT_FF2_HI = CVT_IN + 8192, CVT_TOT = CVT_IN + 2 * 4096 + 1024 + 4 * 256 + 64;
__device__ __forceinline__ void phase_convert(const Params& p, int l, unsigned char* smem, int lo, int hi, int first_blk_256) {
  const int first_blk = (gridDim.x == 256u) ? first_blk_256 : 0;
  bf16_t* tl = (bf16_t*)smem;
  const int TOT = hi;
  const int tid = otid(), G = (int)gridDim.x - first_blk;
  if ((int)blockIdx.x < first_blk) return;
  for (int t0 = lo + (int)blockIdx.x - first_blk; t0 < TOT; t0 += 8 * G) {
    f32x4 v[8][2];
#pragma unroll
    for (int q = 0; q < 8; ++q) {
      const int t = t0 + q * G;
      v[q][0] = (f32x4){0.f, 0.f, 0.f, 0.f}; v[q][1] = v[q][0];
      if (t < TOT) {
        const CvtTile c = cvt_lookup(p, l, t);
#pragma unroll
        for (int ps = 0; ps < 2; ++ps) { const int kk = (tid >> 4) + 32 * ps, n4 = (tid & 15) * 4; if (c.is8 || c.n0 + n4 < c.N) v[q][ps] = *(const f32x4*)(c.src + (size_t)(c.k0 + kk) * c.N + c.n0 + n4);
          if (c.is8) { const f32x4 cm = *(const f32x4*)((const float*)(p.ws + OFF_SC) + TT + c.n0 + n4);
#pragma unroll
            for (int j = 0; j < 4; ++j) v[q][ps][j] = fminf(fmaxf(rintf(v[q][ps][j] * (127.0f / cm[j])), -127.f), 127.f); } }
      }
    }
    const bool grp8 = (t0 < TOT) && cvt_lookup(p, l, t0).is8 && (t0 + 7 * G < CVT_IN) ;
#pragma unroll
    for (int q = 0; q < 8; ++q) {
      const int t = t0 + q * G;
      const bool is8 = (t < TOT) && (t >= 32 * (7424 / 64)) && (t < CVT_IN);
#pragma unroll
      for (int ps = 0; ps < 2; ++ps) { const int kk = (tid >> 4) + 32 * ps, n4 = (tid & 15) * 4;
        if (is8) {
#pragma unroll
          for (int j = 0; j < 4; ++j) ((signed char*)(tl + q * 4608))[(n4 + j) * 80 + kk] = (signed char)(int)v[q][ps][j];
        } else {
#pragma unroll
          for (int j = 0; j < 4; ++j) tl[q * 4608 + (n4 + j) * 72 + kk] = f2bf(v[q][ps][j]);
        } }
    }
    (void)grp8;
    __syncthreads();
#pragma unroll
    for (int q = 0; q < 8; ++q) {
      const int t = t0 + q * G;
      if (t < TOT) { const CvtTile c = cvt_lookup(p, l, t);
        if (c.is8) { if (tid < 256) { const int n = tid >> 2, sg = tid & 3;
            *(u32x4*)((signed char*)c.dst + (size_t)(c.n0 + n) * 2048 + c.k0 + 16 * sg) = *(const u32x4*)((const signed char*)(tl + q * 4608) + n * 80 + 16 * sg); } }
        else { const int n = tid >> 3, k8 = (tid & 7) * 8;
          *(u32x4*)(c.dst + (size_t)(c.n0 + n) * c.K + c.k0 + k8) = *(const u32x4*)(tl + q * 4608 + n * 72 + k8); } }
    }
    __syncthreads();
  }
}

__device__ __forceinline__ void phase_norm(const float* xlat, const float* xctx, int nrows, const float* gw, const float* mod, int soff, bf16_t* dst, signed char* h8 = nullptr, float* rowscale = nullptr) {
  const int tid_ = otid(); const int lane = tid_ & 63, gwv = blockIdx.x * 8 + (tid_ >> 6), nw = gridDim.x * 8;
  for (int row = gwv; row < nrows; row += nw) {
    const float* xr = row < TL ? xlat + (size_t)row * 2048 : xctx + (size_t)(row - TL) * 2048;
    const float* mp = mod + (size_t)(row < TL ? (row >> 12) : 4) * NMOD + soff;
    f32x4 v[8]; float ss = 0.f;
#pragma unroll
    for (int i = 0; i < 8; ++i) { v[i] = *(const f32x4*)(xr + i * 256 + lane * 4); ss += v[i][0] * v[i][0] + v[i][1] * v[i][1] + v[i][2] * v[i][2] + v[i][3] * v[i][3]; }
    ss = wave_sum(ss);
    const float r = rsqrtf(ss * (1.0f / 2048.0f) + 1e-6f);
#pragma unroll
    for (int i = 0; i < 8; ++i) {
      const int c = i * 256 + lane * 4;
      const f32x4 g4 = *(const f32x4*)(gw + c), sh = *(const f32x4*)(mp + c), sc = *(const f32x4*)(mp + 2048 + c);
      f32x4 y;
#pragma unroll
      for (int j = 0; j < 4; ++j) y[j] = v[i][j] * r * g4[j] * (1.0f + sc[j]) + sh[j];
      u32x2 w; w.x = cvt_pk_bf16(y[0], y[1]); w.y = cvt_pk_bf16(y[2], y[3]);
      *(u32x2*)(dst + (size_t)row * 2048 + c) = w;
      v[i] = y;
    }
    if (h8 != nullptr) {
      float mx = 0.f;
#pragma unroll
      for (int i = 0; i < 8; ++i) mx = fmaxf(mx, fmaxf(fmaxf(fabsf(v[i][0]), fabsf(v[i][1])), fmaxf(fabsf(v[i][2]), fabsf(v[i][3]))));
#pragma unroll
      for (int m2 = 32; m2 >= 1; m2 >>= 1) mx = fmaxf(mx, __shfl_xor(mx, m2));
      mx = fmaxf(mx, 1e-30f);
      const float inv = 127.0f / mx;
      if (lane == 0) rowscale[row] = mx * (1.0f / 127.0f);
#pragma unroll
      for (int i = 0; i < 8; ++i) {
        const int c = i * 256 + lane * 4;
        const int q0 = (int)rintf(v[i][0] * inv), q1 = (int)rintf(v[i][1] * inv), q2 = (int)rintf(v[i][2] * inv), q3 = (int)rintf(v[i][3] * inv);
        *(unsigned*)(h8 + (size_t)row * 2048 + c) = (unsigned)(q0 & 255) | ((unsigned)(q1 & 255) << 8) | ((unsigned)(q2 & 255) << 16) | ((unsigned)(q3 & 255) << 24);
      }
    }
  }
}
__device__ __forceinline__ void phase_final_norm(float* x, const float* gw) {
  const int tid_ = otid(); const int lane = tid_ & 63, gwv = blockIdx.x * 8 + (tid_ >> 6), nw = gridDim.x * 8;
  for (int row = gwv; row < TL; row += nw) {
    float* xr = x + (size_t)row * 2048;
    f32x4 v[8]; float ss = 0.f;
#pragma unroll
    for (int i = 0; i < 8; ++i) { v[i] = *(const f32x4*)(xr + i * 256 + lane * 4); ss += v[i][0] * v[i][0] + v[i][1] * v[i][1] + v[i][2] * v[i][2] + v[i][3] * v[i][3]; }
    ss = wave_sum(ss);
    const float r = rsqrtf(ss * (1.0f / 2048.0f) + 1e-6f);
#pragma unroll
    for (int i = 0; i < 8; ++i) { const int c = i * 256 + lane * 4; const f32x4 g4 = *(const f32x4*)(gw + c); *(f32x4*)(xr + c) = v[i] * r * g4; }
  }
}

__device__ __forceinline__ void phase_conv(const Params& p, int l) {
  const bf16_t* cols = (const bf16_t*)(p.ws + OFF_COLS);
  bf16_t* qk = (bf16_t*)(p.ws + OFF_QK);
  const float* cw = p.in[23] + (size_t)l * 9 * 1024; const float* cb = p.in[24] + (size_t)l * 1024;
  const int tid = otid(), c8 = (tid & 127) * 8;
  for (int it = blockIdx.x; it < TT / 4; it += gridDim.x) {
    const int row = it * 4 + (tid >> 7);
    int base, r, cc, R, W;
    if (row < TL) { const int b = row >> 12, t = row & 4095; base = b * 4096; r = t >> 6; cc = t & 63; R = 64; W = 64; }
    else { const int rr = row - TL, b = rr >> 8; base = TL + b * 256; r = 0; cc = rr & 255; R = 1; W = 256; }
    float a[8];
    { const f32x4 b0 = *(const f32x4*)(cb + c8), b1 = *(const f32x4*)(cb + c8 + 4);
#pragma unroll
      for (int j = 0; j < 4; ++j) { a[j] = b0[j]; a[4 + j] = b1[j]; } }
#pragma unroll
    for (int ky = 0; ky < 3; ++ky) {
      const int r2 = r + ky - 1; if (r2 < 0 || r2 >= R) continue;
#pragma unroll
      for (int kx = 0; kx < 3; ++kx) {
        const int c2 = cc + kx - 1; if (c2 < 0 || c2 >= W) continue;
        const u32x4 raw = *(const u32x4*)(cols + (size_t)(base + r2 * W + c2) * NIN + C_MQK + c8);
        const f32x4 w0 = *(const f32x4*)(cw + (ky * 3 + kx) * 1024 + c8), w1 = *(const f32x4*)(cw + (ky * 3 + kx) * 1024 + c8 + 4);
        a[0] += bflo(raw.x) * w0[0]; a[1] += bfhi(raw.x) * w0[1]; a[2] += bflo(raw.y) * w0[2]; a[3] += bfhi(raw.y) * w0[3];
        a[4] += bflo(raw.z) * w1[0]; a[5] += bfhi(raw.z) * w1[1]; a[6] += bflo(raw.w) * w1[2]; a[7] += bfhi(raw.w) * w1[3];
      }
    }
    const float sc = (c8 >= 512) ? 0.08838834764831845f : 1.0f;
#pragma unroll
    for (int j = 0; j < 8; ++j) a[j] = siluf(a[j]) * sc;
    u32x4 w; w.x = cvt_pk_bf16(a[0], a[1]); w.y = cvt_pk_bf16(a[2], a[3]); w.z = cvt_pk_bf16(a[4], a[5]); w.w = cvt_pk_bf16(a[6], a[7]);
    *(u32x4*)(qk + (size_t)row * 1024 + c8) = w;
  }
}

__device__ __forceinline__ void chunk_base(int ci, int b, int dir, int& base, int& sgn) {
  const int start = ci < 4 ? TL + b * 256 + (dir ? 3 - ci : ci) * 64 : b * 4096 + (dir ? 67 - ci : ci - 4) * 64;
  base = dir ? start + 63 : start; sgn = dir ? -1 : 1;
}
__device__ __forceinline__ bf16x8 lds_frag(const bf16_t* p) { return *(const bf16x8*)p; }

template <int KIND  >
__device__ __forceinline__ void scan_matrix_chunk(const Params& p, int l, int b, int h, int dir, int vh, unsigned char* smem) {
  constexpr int NV = (KIND == 3) ? 5 : 4;
  bf16_t* Qa = (bf16_t*)smem;
  bf16_t* Ka = Qa + 64 * 136;
  bf16_t* Qb = Ka + 64 * 136;
  bf16_t* Kt = Qb + 64 * 136;
  bf16_t* Vt = Kt + 128 * 72;
  bf16_t* Pm = Vt + 80 * 72;
  bf16_t* St = Pm + 64 * 72;
  float* segtot = (float*)(St + 80 * 136);
  float* delta = segtot + 1024;
  float* aq = delta + 128; float* clampv = aq + 256; float* dsc = clampv + 64;
  const bf16_t* cols = (const bf16_t*)(p.ws + OFF_COLS);
  const bf16_t* qkb = (const bf16_t*)(p.ws + OFF_QK);
  bf16_t* raw = (bf16_t*)(p.ws + OFF_RAW) + (size_t)(KIND * 2 + dir) * TT * 512 + h * 128 + vh * 64;
  const int tid = otid(), lane = tid & 63, wid = tid >> 6, l15 = lane & 15, lq = lane >> 4;
  const int dp = tid & 63, sg8 = tid >> 6, vcol = tid & 63, s8 = tid >> 6;
  const bf16_t* qsrc; const bf16_t* ksrc; size_t qstr;
  if (KIND == 0) { qsrc = cols + C_HQ + h * 128 + 2 * dp; ksrc = cols + C_HF + dir * 512 + h * 128 + 2 * dp; qstr = NIN; }
  else if (KIND == 1) { qsrc = cols + C_RQ + h * 128 + 2 * dp; ksrc = cols + C_RK + h * 128 + 2 * dp; qstr = NIN; }
  else { qsrc = qkb + h * 128 + 2 * dp; ksrc = qkb + 512 + h * 128 + 2 * dp; qstr = 1024; }
  const bf16_t* vsrc = cols + (KIND == 0 ? C_HV : KIND == 1 ? C_RV : C_MV) + h * 128 + vh * 64 + vcol;
  const bf16_t* gsrc = cols + C_MG + dir * 8 + h;
  float lb0 = 0.f, lb1 = 0.f;
  if (KIND == 0 && l == 1) { const int ch = h * 128 + 2 * dp;
    lb0 = 1.0f / (1.0f + expf(p.in[9][(0 * 2 + dir) * 512 + ch] - p.in[9][(1 * 2 + dir) * 512 + ch]));
    lb1 = 1.0f / (1.0f + expf(p.in[9][(0 * 2 + dir) * 512 + ch + 1] - p.in[9][(1 * 2 + dir) * 512 + ch + 1])); }
  float lg = 0.f;
  if (KIND == 1) lg = log1pf(-expf(p.in[11][(l * 2 + dir) * 4 + h]));
  float gbi = 0.f, gbf = 0.f;
  if (KIND == 3) { gbi = p.in[25][l * 16 + dir * 8 + h]; gbf = p.in[25][l * 16 + dir * 8 + 4 + h]; }
  for (int i = tid; i < 80 * 136 / 2; i += 512) ((unsigned*)St)[i] = 0u;
  for (int i = tid; i < 16 * 72 / 2; i += 512) ((unsigned*)(Vt + 64 * 72))[i] = (KIND == 3) ? 0x3F803F80u : 0u;
  f32x4 accS[NV];
#pragma unroll
  for (int i = 0; i < NV; ++i) accS[i] = (f32x4){0.f, 0.f, 0.f, 0.f};
  float mprev = 0.f;
  const bool wctx = (l == 0);
  unsigned rq[8], rk[8]; unsigned short rv[8]; unsigned short rgi = 0, rgf = 0;
  int base, sgn;
  chunk_base(0, b, dir, base, sgn);
#pragma unroll
  for (int i = 0; i < 8; ++i) { const size_t row = (size_t)(base + sgn * (8 * sg8 + i)); rq[i] = *(const unsigned*)(qsrc + row * qstr); rk[i] = *(const unsigned*)(ksrc + row * qstr); }
#pragma unroll
  for (int i = 0; i < 8; ++i) rv[i] = vsrc[(size_t)(base + sgn * (8 * s8 + i)) * NIN];
  if (KIND == 3 && wid == 0) { const size_t row = (size_t)(base + sgn * lane); rgi = gsrc[row * NIN]; rgf = gsrc[row * NIN + 4]; }
  __syncthreads();
  for (int ci = 0; ci < 68; ++ci) {
    const int cbase = base, csgn = sgn;
    if (KIND == 3) {
      if (wid == 0) {
        const float gi = bf2f(rgi) + gbi, gfv = bf2f(rgf) + gbf;
        const float cum = wave_scan_add(fminf(gfv, 0.f) - __logf(1.0f + __expf(-fabsf(gfv))));
        const float e = gi - cum;
        const float a = wave_scan_max(e);
        const float mx = fmaxf(mprev, a);
        const float mx63 = __builtin_bit_cast(float, __builtin_amdgcn_readlane(__builtin_bit_cast(int, mx), 63)), cum63 = __builtin_bit_cast(float, __builtin_amdgcn_readlane(__builtin_bit_cast(int, cum), 63));
        *(f32x4*)(aq + 4 * lane) = (f32x4){__expf(-mx), __expf(e), __expf(mprev - mx), __expf(e - mx63)}; clampv[lane] = __expf(-cum - mx);
        if (lane == 0) dsc[0] = __expf(mprev - mx63);
        mprev = cum63 + mx63;
      }
      __syncthreads();
    }
    {
      float kb0[8], kb1[8];
      if (KIND == 0) {
        const f32x2_t lb = {lb0, lb1}, oml = 1.0f - lb;
        f32x2_t c[8], kk[8]; f32x2_t run = {1.f, 1.f};
#pragma unroll
        for (int i = 0; i < 8; ++i) {
          const f32x2_t z = {bflo(rk[i]), bfhi(rk[i])}, zs = z * (-1.4426950408889634f);
          const f32x2_t ez = {__builtin_amdgcn_exp2f(zs.x), __builtin_amdgcn_exp2f(zs.y)}, dn = 1.0f + ez;
          const f32x2_t sg = {__builtin_amdgcn_rcpf(dn.x), __builtin_amdgcn_rcpf(dn.y)};
          const f32x2_t f = __builtin_elementwise_max(lb + oml * sg, (f32x2_t){1e-30f, 1e-30f});
          run *= f; c[i] = run; kk[i] = oml * ez * sg;
        }
        *(f32x2_t*)(segtot + sg8 * 128 + 2 * dp) = run;
        __syncthreads();
        f32x2_t off = {1.f, 1.f}, mid = {1.f, 1.f}, tail = {1.f, 1.f};
#pragma unroll
        for (int j = 0; j < 8; ++j) {
          const f32x2_t a = *(const f32x2_t*)(segtot + j * 128 + 2 * dp);
          if (j < sg8) off *= a;
          if (j < 4) mid *= a;
          tail *= a;
        }
        const f32x2_t rmid = {__builtin_amdgcn_rcpf(fmaxf(mid.x, 1e-37f)), __builtin_amdgcn_rcpf(fmaxf(mid.y, 1e-37f))};
        if (sg8 == 0) *(f32x2_t*)(delta + 2 * dp) = tail;
#pragma unroll
        for (int i = 0; i < 8; ++i) {
          const int t = 8 * sg8 + i;
          const f32x2_t q = {bflo(rq[i]), bfhi(rq[i])};
          const f32x2_t cp = __builtin_elementwise_max(c[i] * off, (f32x2_t){1e-37f, 1e-37f});
          const f32x2_t rc = {__builtin_amdgcn_rcpf(cp.x), __builtin_amdgcn_rcpf(cp.y)};
          const f32x2_t qc = q * cp, qa = qc * rmid, krc = kk[i] * rc, ka = krc * mid, kb = krc * tail;
          *(unsigned*)(Qa + t * 136 + 2 * dp) = cvt_pk_bf16(qa.x, qa.y);
          *(unsigned*)(Ka + t * 136 + 2 * dp) = cvt_pk_bf16(ka.x, ka.y);
          *(unsigned*)(Qb + t * 136 + 2 * dp) = cvt_pk_bf16(qc.x, qc.y);
          kb0[i] = kb.x; kb1[i] = kb.y;
        }
      } else if (KIND == 1) {
        const float gstep = __expf(lg), g63 = __expf(lg * 63.0f);
        float ga = __expf(lg * (float)(8 * sg8));
#pragma unroll
        for (int i = 0; i < 8; ++i) {
          const int t = 8 * sg8 + i;
          const float q0 = bflo(rq[i]), q1 = bfhi(rq[i]), k0 = bflo(rk[i]) * 0.08838834764831845f, k1 = bfhi(rk[i]) * 0.08838834764831845f;
          const float rga = __builtin_amdgcn_rcpf(ga);
          *(unsigned*)(Qa + t * 136 + 2 * dp) = cvt_pk_bf16(q0 * ga, q1 * ga);
          *(unsigned*)(Ka + t * 136 + 2 * dp) = cvt_pk_bf16(k0 * rga, k1 * rga);
          *(unsigned*)(Qb + t * 136 + 2 * dp) = cvt_pk_bf16(q0 * ga * gstep, q1 * ga * gstep);
          kb0[i] = k0 * g63 * rga; kb1[i] = k1 * g63 * rga;
          ga *= gstep;
        }
      } else {
#pragma unroll
        for (int i = 0; i < 8; ++i) {
          const int t = 8 * sg8 + i;
          const f32x4 sc = *(const f32x4*)(aq + 4 * t);
          const float q0 = bflo(rq[i]), q1 = bfhi(rq[i]), k0 = bflo(rk[i]), k1 = bfhi(rk[i]);
          *(unsigned*)(Qa + t * 136 + 2 * dp) = cvt_pk_bf16(q0 * sc[0], q1 * sc[0]);
          *(unsigned*)(Ka + t * 136 + 2 * dp) = cvt_pk_bf16(k0 * sc[1], k1 * sc[1]);
          *(unsigned*)(Qb + t * 136 + 2 * dp) = cvt_pk_bf16(q0 * sc[2], q1 * sc[2]);
          kb0[i] = k0 * sc[3]; kb1[i] = k1 * sc[3];
        }
      }
      u32x4 w0, w1;
      w0.x = cvt_pk_bf16(kb0[0], kb0[1]); w0.y = cvt_pk_bf16(kb0[2], kb0[3]); w0.z = cvt_pk_bf16(kb0[4], kb0[5]); w0.w = cvt_pk_bf16(kb0[6], kb0[7]);
      w1.x = cvt_pk_bf16(kb1[0], kb1[1]); w1.y = cvt_pk_bf16(kb1[2], kb1[3]); w1.z = cvt_pk_bf16(kb1[4], kb1[5]); w1.w = cvt_pk_bf16(kb1[6], kb1[7]);
      *(u32x4*)(Kt + (2 * dp) * 72 + 8 * sg8) = w0; *(u32x4*)(Kt + (2 * dp + 1) * 72 + 8 * sg8) = w1;
      u32x4 wv; wv.x = (unsigned)rv[0] | ((unsigned)rv[1] << 16); wv.y = (unsigned)rv[2] | ((unsigned)rv[3] << 16);
      wv.z = (unsigned)rv[4] | ((unsigned)rv[5] << 16); wv.w = (unsigned)rv[6] | ((unsigned)rv[7] << 16);
      *(u32x4*)(Vt + vcol * 72 + 8 * s8) = wv;
    }
    if (ci + 1 < 68) {
      chunk_base(ci + 1, b, dir, base, sgn);
#pragma unroll
      for (int i = 0; i < 8; ++i) { const size_t row = (size_t)(base + sgn * (8 * sg8 + i)); rq[i] = *(const unsigned*)(qsrc + row * qstr); rk[i] = *(const unsigned*)(ksrc + row * qstr); }
#pragma unroll
      for (int i = 0; i < 8; ++i) rv[i] = vsrc[(size_t)(base + sgn * (8 * s8 + i)) * NIN];
      if (KIND == 3 && wid == 0) { const size_t row = (size_t)(base + sgn * lane); rgi = gsrc[row * NIN]; rgf = gsrc[row * NIN + 4]; }
    }
    __syncthreads();
    const bool need_out = wctx || ci >= 4;
    if (need_out) {
      const int tm = wid >> 1, tn0 = (wid & 1) * 2;
      bf16x8 af[4];
#pragma unroll
      for (int kd = 0; kd < 4; ++kd) af[kd] = lds_frag(Qa + (16 * tm + l15) * 136 + 32 * kd + 8 * lq);
#pragma unroll
      for (int tt = 0; tt < 2; ++tt) {
        const int tn = tn0 + tt;
        f32x4 acc = (f32x4){0.f, 0.f, 0.f, 0.f};
#pragma unroll
        for (int kd = 0; kd < 4; ++kd) acc = __builtin_amdgcn_mfma_f32_16x16x32_bf16(af[kd], lds_frag(Ka + (16 * tn + l15) * 136 + 32 * kd + 8 * lq), acc, 0, 0, 0);
#pragma unroll
        for (int j = 0; j < 4; ++j) { const int t = 16 * tm + 4 * lq + j, s = 16 * tn + l15; Pm[t * 72 + s] = f2bf_hw(t >= s ? acc[j] : 0.f); }
      }
    }
    __syncthreads();
    {
      const int tm = wid >> 1, tv0 = (wid & 1) * 2;
      bf16x8 aP[2], aQ[4];
#pragma unroll
      for (int ks = 0; ks < 2; ++ks) aP[ks] = lds_frag(Pm + (16 * tm + l15) * 72 + 32 * ks + 8 * lq);
#pragma unroll
      for (int kd = 0; kd < 4; ++kd) aQ[kd] = lds_frag(Qb + (16 * tm + l15) * 136 + 32 * kd + 8 * lq);
      f32x4 den = (f32x4){1.f, 1.f, 1.f, 1.f};
      if (KIND == 3 && need_out) {
        f32x4 acc = (f32x4){0.f, 0.f, 0.f, 0.f};
#pragma unroll
        for (int ks = 0; ks < 2; ++ks) acc = __builtin_amdgcn_mfma_f32_16x16x32_bf16(aP[ks], lds_frag(Vt + (64 + l15) * 72 + 32 * ks + 8 * lq), acc, 0, 0, 0);
#pragma unroll
        for (int kd = 0; kd < 4; ++kd) acc = __builtin_amdgcn_mfma_f32_16x16x32_bf16(aQ[kd], lds_frag(St + (64 + l15) * 136 + 32 * kd + 8 * lq), acc, 0, 0, 0);
        const f32x4 cl = *(const f32x4*)(clampv + 16 * tm + 4 * lq);
#pragma unroll
        for (int j = 0; j < 4; ++j) den[j] = 1.0f / fmaxf(fabsf(acc[j]), cl[j]);
      }
      const bool wr_out = need_out;
      if (need_out)
#pragma unroll
      for (int tt = 0; tt < 2; ++tt) {
        const int tv = tv0 + tt;
        f32x4 acc = (f32x4){0.f, 0.f, 0.f, 0.f};
#pragma unroll
        for (int ks = 0; ks < 2; ++ks) acc = __builtin_amdgcn_mfma_f32_16x16x32_bf16(aP[ks], lds_frag(Vt + (16 * tv + l15) * 72 + 32 * ks + 8 * lq), acc, 0, 0, 0);
#pragma unroll
        for (int kd = 0; kd < 4; ++kd) acc = __builtin_amdgcn_mfma_f32_16x16x32_bf16(aQ[kd], lds_frag(St + (16 * tv + l15) * 136 + 32 * kd + 8 * lq), acc, 0, 0, 0);
        if (wr_out) {
#pragma unroll
          for (int j = 0; j < 4; ++j) { const int t = 16 * tm + 4 * lq + j; raw[(size_t)(cbase + csgn * t) * 512 + 16 * tv + l15] = f2bf_hw(KIND == 3 ? acc[j] * den[j] : acc[j]); }
        }
      }
      bf16x8 aK[2];
#pragma unroll
      for (int ks = 0; ks < 2; ++ks) aK[ks] = lds_frag(Kt + (16 * wid + l15) * 72 + 32 * ks + 8 * lq);
      f32x4 dl;
      if (KIND == 0) dl = *(const f32x4*)(delta + 16 * wid + 4 * lq);
      else { const float dv = (KIND == 1) ? __expf(lg * 64.0f) : dsc[0]; dl = (f32x4){dv, dv, dv, dv}; }
#pragma unroll
      for (int tv = 0; tv < NV; ++tv) {
        accS[tv] = accS[tv] * dl;
#pragma unroll
        for (int ks = 0; ks < 2; ++ks) accS[tv] = __builtin_amdgcn_mfma_f32_16x16x32_bf16(aK[ks], lds_frag(Vt + (16 * tv + l15) * 72 + 32 * ks + 8 * lq), accS[tv], 0, 0, 0);
      }
    }
    __syncthreads();
#pragma unroll
    for (int tv = 0; tv < NV; ++tv) { u32x2 w; w.x = cvt_pk_bf16(accS[tv][0], accS[tv][1]); w.y = cvt_pk_bf16(accS[tv][2], accS[tv][3]); *(u32x2*)(St + (16 * tv + l15) * 136 + 16 * wid + 4 * lq) = w; }
  }
  __syncthreads();
}

__device__ __forceinline__ void scan_s5_chunk(const Params& p, int l, int b, int dir, int gq, unsigned char* smem) {
  const int tid = otid(), lane = tid & 63, wid = tid >> 6, g = gq * 4 + wid, l15 = lane & 15, lq = lane >> 4;
  if (wid >= 4) return;
  bf16_t* XB = (bf16_t*)smem + wid * (64 * 136);
  const bf16_t* cols = (const bf16_t*)(p.ws + OFF_COLS);
  bf16_t* raw = (bf16_t*)(p.ws + OFF_RAW) + (size_t)(2 * 2 + dir) * TT * 512 + g * 16 + l15;
  const size_t ld = (size_t)(l * 2 + dir);
  const float dt = expf(p.in[15][ld * 32 + g]);
  float lam_re, lam_im;
  { const float a_re = p.in[13][(ld * 32 + g) * 64 + lane], a_im = p.in[14][(ld * 32 + g) * 64 + lane]; const float mag = expf(a_re * dt), th = a_im * dt; lam_re = mag * cosf(th); lam_im = mag * sinf(th); }
  bf16x8 abb[8];
  {
    const int hq = (lq & 1) * 8;
#pragma unroll 1
    for (int mt = 0; mt < 8; ++mt) {
      const int pp = (16 * mt + l15) >> 1, im = l15 & 1;
      const size_t ix = ((ld * 32 + g) * 64 + pp) * 16 + hq;
      const f32x4 br0 = *(const f32x4*)(p.in[16] + ix), br1 = *(const f32x4*)(p.in[16] + ix + 4);
      const f32x4 bi0 = *(const f32x4*)(p.in[17] + ix), bi1 = *(const f32x4*)(p.in[17] + ix + 4);
      const float a_re = p.in[13][(ld * 32 + g) * 64 + pp], a_im = p.in[14][(ld * 32 + g) * 64 + pp];
      const float mag = expf(a_re * dt), th = a_im * dt, lr = mag * cosf(th), li = mag * sinf(th);
      const float dn = a_re * a_re + a_im * a_im, nr = lr - 1.0f, ni = li;
      float fr = (nr * a_re + ni * a_im) / dn, fi = (ni * a_re - nr * a_im) / dn;
      if (lq >= 2) { fr = 0.f; fi = 0.f; }
      float o[8];
#pragma unroll
      for (int j = 0; j < 4; ++j) {
        o[j] = im ? (fr * bi0[j] + fi * br0[j]) : (fr * br0[j] - fi * bi0[j]);
        o[4 + j] = im ? (fr * bi1[j] + fi * br1[j]) : (fr * br1[j] - fi * bi1[j]);
      }
      u32x4 w; w.x = cvt_pk_bf16(o[0], o[1]); w.y = cvt_pk_bf16(o[2], o[3]); w.z = cvt_pk_bf16(o[4], o[5]); w.w = cvt_pk_bf16(o[6], o[7]);
      *(u32x4*)(XB + mt * 512 + lane * 8) = w;
    }
    asm volatile("s_waitcnt lgkmcnt(0)" ::: "memory");
#pragma unroll
    for (int mt = 0; mt < 8; ++mt) abb[mt] = lds_frag(XB + mt * 512 + lane * 8);
    asm volatile("s_waitcnt lgkmcnt(0)" ::: "memory");
  }
  bf16x8 ccf[4];
#pragma unroll
  for (int kk = 0; kk < 4; ++kk) {
    const size_t ix = ((ld * 32 + g) * 16 + l15) * 64 + 16 * kk + 4 * lq;
    const f32x4 cr = *(const f32x4*)(p.in[18] + ix), cim = *(const f32x4*)(p.in[19] + ix);
#pragma unroll
    for (int j = 0; j < 4; ++j) { ccf[kk][2 * j] = (short)f2bf(cr[j]); ccf[kk][2 * j + 1] = (short)f2bf(-cim[j]); }
  }
  float xr = 0.f, xi = 0.f;
  const bool wctx = (l == 0);
  int base, sgn;
  chunk_base(0, b, dir, base, sgn);
  u32x4 ufr[4];
#pragma unroll
  for (int nt = 0; nt < 4; ++nt) { ufr[nt] = (u32x4){0u, 0u, 0u, 0u}; if (lq < 2) ufr[nt] = *(const u32x4*)(cols + (size_t)(base + sgn * (16 * nt + l15)) * NIN + C_SU + g * 16 + 8 * lq); }
  for (int ci = 0; ci < 68; ++ci) {
    const int cbase = base, csgn = sgn;
#pragma unroll
    for (int nt = 0; nt < 4; ++nt) {
      const bf16x8 bu = __builtin_bit_cast(bf16x8, ufr[nt]);
      f32x4 a8[8];
#pragma unroll
      for (int mt = 0; mt < 8; ++mt) a8[mt] = __builtin_amdgcn_mfma_f32_16x16x32_bf16(abb[mt], bu, (f32x4){0.f, 0.f, 0.f, 0.f}, 0, 0, 0);
#pragma unroll
      for (int mt = 0; mt < 8; ++mt) {
        u32x2 w; w.x = cvt_pk_bf16(a8[mt][0], a8[mt][1]); w.y = cvt_pk_bf16(a8[mt][2], a8[mt][3]);
        *(u32x2*)(XB + (16 * nt + l15) * 136 + 16 * mt + 4 * lq) = w;
      }
    }
    if (ci + 1 < 68) {
      chunk_base(ci + 1, b, dir, base, sgn);
#pragma unroll
      for (int nt = 0; nt < 4; ++nt) if (lq < 2) ufr[nt] = *(const u32x4*)(cols + (size_t)(base + sgn * (16 * nt + l15)) * NIN + C_SU + g * 16 + 8 * lq);
    }
    asm volatile("s_waitcnt lgkmcnt(0)" ::: "memory");
    {
      unsigned* xw = (unsigned*)XB + lane;
      unsigned nx[8];
#pragma unroll
      for (int i = 0; i < 8; ++i) nx[i] = xw[i * 68];
#pragma unroll 1
      for (int blk = 0; blk < 8; ++blk) {
        unsigned cw[8];
#pragma unroll
        for (int i = 0; i < 8; ++i) cw[i] = nx[i];
        if (blk < 7) {
#pragma unroll
          for (int i = 0; i < 8; ++i) nx[i] = xw[((blk + 1) * 8 + i) * 68];
        }
#pragma unroll
        for (int i = 0; i < 8; ++i) {
          const float nxr = lam_re * xr - lam_im * xi + bflo(cw[i]), nxi = lam_re * xi + lam_im * xr + bfhi(cw[i]);
          xr = nxr; xi = nxi;
          xw[(blk * 8 + i) * 68] = cvt_pk_bf16(xr, xi);
        }
      }
    }
    asm volatile("s_waitcnt lgkmcnt(0)" ::: "memory");
    if (wctx || ci >= 4) {
      f32x4 ya[4];
#pragma unroll
      for (int mt = 0; mt < 4; ++mt) ya[mt] = (f32x4){0.f, 0.f, 0.f, 0.f};
#pragma unroll
      for (int kk = 0; kk < 4; ++kk)
#pragma unroll
        for (int mt = 0; mt < 4; ++mt) ya[mt] = __builtin_amdgcn_mfma_f32_16x16x32_bf16(lds_frag(XB + (16 * mt + l15) * 136 + 32 * kk + 8 * lq), ccf[kk], ya[mt], 0, 0, 0);
#pragma unroll
      for (int mt = 0; mt < 4; ++mt)
#pragma unroll
        for (int j = 0; j < 4; ++j) raw[(size_t)(cbase + csgn * (16 * mt + 4 * lq + j)) * 512] = f2bf_hw(ya[mt][j]);
    }
    asm volatile("s_waitcnt lgkmcnt(0)" ::: "memory");
  }
}

#ifndef MATRIX_CHUNK
#define MATRIX_CHUNK 1
#endif
#ifndef S5_CHUNK
#define S5_CHUNK 1
#endif
#ifndef PROBE_KIND
#define PROBE_KIND -1
#endif
__device__ __forceinline__ void phase_scan(const Params& p, int l, unsigned char* smem) {
  for (int item = blockIdx.x; item < 256; item += gridDim.x) {
    const int kindx = item < 192 ? (item >> 6) : 3;
    const int reps = (kindx == PROBE_KIND) ? 2 : 1;
    for (int rep = 0; rep < reps; ++rep) {
    if (item < 192) {
      const int kind = item >> 6, r = item & 63, b = r >> 4, h = (r >> 2) & 3, dir = (r >> 1) & 1, vh = r & 1;
      if (kind == 0) scan_matrix_chunk<0>(p, l, b, h, dir, vh, smem);
      else if (kind == 1) scan_matrix_chunk<1>(p, l, b, h, dir, vh, smem);
      else scan_matrix_chunk<3>(p, l, b, h, dir, vh, smem);
    } else {
      const int r = item - 192;
      scan_s5_chunk(p, l, r >> 4, (r >> 3) & 1, r & 7, smem);
    }
    }
  }
}

__device__ __forceinline__ void phase_finish(const Params& p, int l, int nrows) {
  const bf16_t* cols = (const bf16_t*)(p.ws + OFF_COLS);
  const bf16_t* raw = (const bf16_t*)(p.ws + OFF_RAW);
  bf16_t* O = (bf16_t*)(p.ws + OFF_O); bf16_t* YC = (bf16_t*)(p.ws + OFF_YC);
  const int tid_ = otid(); const int lane = tid_ & 63, gwv = blockIdx.x * 8 + (tid_ >> 6), nw = gridDim.x * 8, c8 = lane * 8;
  for (int row = gwv; row < nrows; row += nw) {
    const bf16_t* cr = cols + (size_t)row * NIN;
#pragma unroll
    for (int kk = 0; kk < 3; ++kk) {
      const int kind = kk == 2 ? 3 : kk;
      const float* nwp = (kk == 0 ? p.in[10] : kk == 1 ? p.in[12] : p.in[26]) + l * 512 + c8;
      const int gcol = kk == 0 ? C_HG : kk == 1 ? C_RG : C_MZ, ocol = kk == 0 ? 0 : kk == 1 ? 512 : 1536;
      const u32x4 q0 = *(const u32x4*)(raw + ((size_t)(kind * 2 + 0) * TT + row) * 512 + c8), q1 = *(const u32x4*)(raw + ((size_t)(kind * 2 + 1) * TT + row) * 512 + c8);
      const f32x4 a0 = (f32x4){bflo(q0.x) + bflo(q1.x), bfhi(q0.x) + bfhi(q1.x), bflo(q0.y) + bflo(q1.y), bfhi(q0.y) + bfhi(q1.y)};
      const f32x4 a1 = (f32x4){bflo(q0.z) + bflo(q1.z), bfhi(q0.z) + bfhi(q1.z), bflo(q0.w) + bflo(q1.w), bfhi(q0.w) + bfhi(q1.w)};
      float ss = a0[0] * a0[0] + a0[1] * a0[1] + a0[2] * a0[2] + a0[3] * a0[3] + a1[0] * a1[0] + a1[1] * a1[1] + a1[2] * a1[2] + a1[3] * a1[3];
      ss += __shfl_xor(ss, 1); ss += __shfl_xor(ss, 2); ss += __shfl_xor(ss, 4); ss += __shfl_xor(ss, 8);
      const float rn = rsqrtf(ss * (1.0f / 128.0f) + 1e-6f);
      const f32x4 w0 = *(const f32x4*)nwp, w1 = *(const f32x4*)(nwp + 4);
      const u32x4 gt = *(const u32x4*)(cr + gcol + c8);
      const float gg[8] = {bflo(gt.x), bfhi(gt.x), bflo(gt.y), bfhi(gt.y), bflo(gt.z), bfhi(gt.z), bflo(gt.w), bfhi(gt.w)};
      float o[8];
#pragma unroll
      for (int j = 0; j < 4; ++j) { o[j] = a0[j] * rn * w0[j] * siluf(gg[j]); o[4 + j] = a1[j] * rn * w1[j] * siluf(gg[4 + j]); }
      u32x4 w; w.x = cvt_pk_bf16(o[0], o[1]); w.y = cvt_pk_bf16(o[2], o[3]); w.z = cvt_pk_bf16(o[4], o[5]); w.w = cvt_pk_bf16(o[6], o[7]);
      *(u32x4*)(O + (size_t)row * 2048 + ocol + c8) = w;
    }
    {
      const u32x4 q0 = *(const u32x4*)(raw + ((size_t)(2 * 2 + 0) * TT + row) * 512 + c8), q1 = *(const u32x4*)(raw + ((size_t)(2 * 2 + 1) * TT + row) * 512 + c8);
      const f32x4 a0 = (f32x4){bflo(q0.x) + bflo(q1.x), bfhi(q0.x) + bfhi(q1.x), bflo(q0.y) + bflo(q1.y), bfhi(q0.y) + bfhi(q1.y)};
      const f32x4 a1 = (f32x4){bflo(q0.z) + bflo(q1.z), bfhi(q0.z) + bfhi(q1.z), bflo(q0.w) + bflo(q1.w), bfhi(q0.w) + bfhi(q1.w)};
      const f32x4 d0 = *(const f32x4*)(p.in[20] + l * 512 + c8), d1 = *(const f32x4*)(p.in[20] + l * 512 + c8 + 4);
      const u32x4 ut = *(const u32x4*)(cr + C_SU + c8);
      const float uu[8] = {bflo(ut.x), bfhi(ut.x), bflo(ut.y), bfhi(ut.y), bflo(ut.z), bfhi(ut.z), bflo(ut.w), bfhi(ut.w)};
      float o[8];
#pragma unroll
      for (int j = 0; j < 4; ++j) { o[j] = a0[j] + d0[j] * uu[j]; o[4 + j] = a1[j] + d1[j] * uu[4 + j]; }
#pragma unroll
      for (int j = 0; j < 8; ++j) o[j] = 0.5f * o[j] * (1.0f + erff(o[j] * 0.7071067811865476f));
      u32x4 w; w.x = cvt_pk_bf16(o[0], o[1]); w.y = cvt_pk_bf16(o[2], o[3]); w.z = cvt_pk_bf16(o[4], o[5]); w.w = cvt_pk_bf16(o[6], o[7]);
      *(u32x4*)(YC + (size_t)row * 512 + c8) = w;
    }
  }
}


#define XB_TMO      128
#define XB_XCNT(j)  (256  + 64 * (j))
#define XB_XSUB(j)  (1280 + 64 * (j))
#define XB_XGEN(j)  (2304 + 64 * (j))
#define XB_TOP      3328
#define XB_TOPGEN   3392
#define XCD_BAR_WORDS 3456
#define XB_SPIN_CAP (1u << 18)
__device__ __forceinline__ unsigned xb_ld(unsigned* p)              { return __hip_atomic_load(p, __ATOMIC_RELAXED, __HIP_MEMORY_SCOPE_AGENT); }
__device__ __forceinline__ unsigned xb_add(unsigned* p, unsigned v) { return __hip_atomic_fetch_add(p, v, __ATOMIC_RELAXED, __HIP_MEMORY_SCOPE_AGENT); }
__device__ __forceinline__ unsigned xb_xcc_id() { return (unsigned)__builtin_amdgcn_s_getreg((3 << 11) | 20) & 0xFu; }
#define XB_SPIN(cond, bar) do { unsigned _sp = 0; while (cond) { __builtin_amdgcn_s_sleep(1); \
    if ((++_sp & 255u) == 0u) { if (xb_ld(&(bar)[XB_TMO])) break; if (_sp > XB_SPIN_CAP) { atomicAdd(&(bar)[XB_TMO], 1u); break; } } } } while (0)
struct XcdBarrier { unsigned* bar; unsigned x; volatile LAS unsigned* st; };
__device__ __forceinline__ XcdBarrier xcd_barrier_post(unsigned* bar, volatile LAS unsigned* st) {
    XcdBarrier b; b.bar = bar; b.x = xb_xcc_id(); b.st = st;
    if (threadIdx.x == 0) (void)xb_add(&bar[XB_XCNT(b.x)], 1u);
    return b;
}
__device__ __forceinline__ void xcd_barrier_complete(unsigned* bar, unsigned x, unsigned& nloc, unsigned& nx) {
    const unsigned G = gridDim.x * gridDim.y * gridDim.z;
    unsigned sum, cnt, mine, sp = 0u;
    for (;;) {
        sum = 0u; cnt = 0u; mine = 0u;
#pragma unroll
        for (unsigned j = 0; j < 16; ++j) { const unsigned c = xb_ld(&bar[XB_XCNT(j)]); sum += c; cnt += (c > 0u) ? 1u : 0u; mine = (j == x) ? c : mine; }
        if (sum == G) break;
        __builtin_amdgcn_s_sleep(1);
        if ((++sp & 255u) == 0u) { if (xb_ld(&bar[XB_TMO])) break; if (sp > XB_SPIN_CAP) { atomicAdd(&bar[XB_TMO], 1u); break; } }
    }
    nloc = mine > 0u ? mine : 1u; nx = cnt > 0u ? cnt : 1u;
}
__device__ __forceinline__ void xcd_barrier(const XcdBarrier& b) {
    asm volatile("s_waitcnt vmcnt(0)" ::: "memory");
    __syncthreads();
    if (threadIdx.x == 0) {
        unsigned* bar = b.bar;
        __builtin_amdgcn_s_waitcnt(0);
        unsigned nloc = b.st[0], nx = b.st[1];
        if (nloc == 0u) { xcd_barrier_complete(bar, b.x, nloc, nx); b.st[0] = nloc; b.st[1] = nx; }
        const unsigned old = xb_add(&bar[XB_XSUB(b.x)], 1u);
        const unsigned gen = old / nloc;
        if (old + 1u == (gen + 1u) * nloc) {
            __builtin_amdgcn_fence(__ATOMIC_RELEASE, "agent");
            asm volatile("s_waitcnt vmcnt(0)" ::: "memory");
            const unsigned og = xb_add(&bar[XB_TOP], 1u);
            const unsigned tg = og / nx;
            if (og + 1u == (tg + 1u) * nx) xb_add(&bar[XB_TOPGEN], 1u);
            else XB_SPIN(xb_ld(&bar[XB_TOPGEN]) == tg, bar);
            __builtin_amdgcn_fence(__ATOMIC_ACQUIRE, "agent");
            xb_add(&bar[XB_XGEN(b.x)], 1u);
            asm volatile("s_waitcnt vmcnt(0)" ::: "memory");
        } else {
            XB_SPIN(xb_ld(&bar[XB_XGEN(b.x)]) == gen, bar);
            __builtin_amdgcn_fence(__ATOMIC_ACQUIRE, "agent");
            asm volatile("s_waitcnt vmcnt(0)" ::: "memory");
        }
    }
    __syncthreads();
}
__device__ __forceinline__ void grid_barrier(const Params& p, unsigned char* smem) {
  XcdBarrier b; b.bar = (unsigned*)(p.ws + OFF_BAR); b.x = xb_xcc_id(); b.st = (volatile LAS unsigned*)(smem + kPhaseLds);
  xcd_barrier(b);
}

#ifndef PROBE_DUP
#define PROBE_DUP 0
#endif
template <int PH>
__device__ __forceinline__ void do_phase(const Params& p, unsigned char* smem) {
  constexpr int l = PH / 11, k = PH % 11;
  constexpr int Ml = (l == 0) ? TT : TL;
  float* mod = (float*)(p.ws + OFF_MOD);
  bf16_t* ACT = (bf16_t*)(p.ws + OFF_ACT);
  float* XC = (float*)(p.ws + OFF_XC);
  const float* xlat = (l == 0) ? p.in[0] : p.out; const float* xctx = (l == 0) ? p.in[2] : XC;
  const float* modl = mod + (size_t)l * 5 * NMOD;
  if constexpr (k == 0) {
    if (l == 0) phase_convert(p, 0, smem, 0, CVT_IN, 0);
    phase_norm(xlat, xctx, TT, p.in[6] + l * 2048, modl, 0, ACT, (signed char*)(p.ws + OFF_H8), (float*)(p.ws + OFF_SC));
  } else if constexpr (k == 2) {
    for (int rep = 0; rep < ((PROBE_DUP & 2) ? 2 : 1); ++rep)
    phase_conv(p, l);
  } else if constexpr (k == 3) {
    for (int rep = 0; rep < ((PROBE_DUP & 1) ? 2 : 1); ++rep)
    phase_scan(p, l, smem);
  } else if constexpr (k == 4) {
    for (int rep = 0; rep < ((PROBE_DUP & 2) ? 2 : 1); ++rep)
    phase_finish(p, l, Ml);
  } else if constexpr (k == 8) {
    for (int rep = 0; rep < ((PROBE_DUP & 2) ? 2 : 1); ++rep)
    phase_norm(p.out, XC, Ml, p.in[7] + l * 2048, modl, 3 * 2048, ACT);
  } else {
    GemmDesc g;
    g.nkz = 1; g.kzA = 0; g.kzB = 0; g.obf = nullptr; g.ldo = 0; g.ncols = 1 << 30; g.gsrc = nullptr; g.bias = nullptr;
    g.xin_lat = nullptr; g.xin_ctx = nullptr; g.xout_lat = nullptr; g.xout_ctx = nullptr; g.mod = modl; g.moff = 0; g.rowscale = nullptr; g.colmax = nullptr;
    if constexpr (k == 1) { g.A = ACT; g.lda = 2048; g.Bt = (const bf16_t*)(p.ws + OFF_WIN); g.ldb = 2048; g.M = TT; g.N = NINP; g.K = 2048; g.epi = E_COLS;
      g.N = 7424; g.obf = (bf16_t*)(p.ws + OFF_COLS); g.ldo = NIN; g.ncols = C_GATE; }
    else if constexpr (k == 5) { g.A = (const bf16_t*)(p.ws + OFF_YC); g.lda = 512; g.Bt = (const bf16_t*)(p.ws + OFF_WGLU); g.ldb = 512; g.M = Ml; g.N = 512; g.K = 512; g.epi = E_GLU;
      g.obf = (bf16_t*)(p.ws + OFF_O) + 1024; g.ldo = 2048; g.gsrc = (const bf16_t*)(p.ws + OFF_YC); g.bias = p.in[22] + l * 512; }
    else if constexpr (k == 6) { g.A = (const bf16_t*)(p.ws + OFF_O); g.lda = 2048; g.Bt = (const bf16_t*)(p.ws + OFF_WBR); g.ldb = 512; g.M = Ml; g.N = 2048; g.K = 512; g.epi = E_MERGE;
      g.nkz = 4; g.kzA = 512 * 2; g.kzB = (size_t)2048 * 512 * 2; g.obf = ACT; g.ldo = 2048; g.gsrc = (const bf16_t*)(p.ws + OFF_COLS); }
    else if constexpr (k == 7) { g.A = ACT; g.lda = 2048; g.Bt = (const bf16_t*)(p.ws + OFF_WOUT); g.ldb = 2048; g.M = Ml; g.N = 2048; g.K = 2048; g.epi = E_RES;
      g.xin_lat = xlat; g.xin_ctx = xctx; g.xout_lat = p.out; g.xout_ctx = XC; g.moff = 2 * 2048; }
    else if constexpr (k == 9) { g.A = ACT; g.lda = 2048; g.Bt = (const bf16_t*)(p.ws + OFF_WFF1); g.ldb = 2048; g.M = Ml; g.N = 8192; g.K = 2048; g.epi = E_RELU2;
      g.obf = (bf16_t*)(p.ws + OFF_U); g.ldo = 8192; }
    else { g.A = (const bf16_t*)(p.ws + OFF_U); g.lda = 8192; g.Bt = (const bf16_t*)(p.ws + OFF_WFF2); g.ldb = 8192; g.M = Ml; g.N = 2048; g.K = 8192; g.epi = E_RES;
      g.xin_lat = p.out; g.xin_ctx = XC; g.xout_lat = p.out; g.xout_ctx = XC; g.moff = 5 * 2048; }
    gemm_phase((LAS unsigned char*)smem, g);
    if constexpr (k == 1) {
      GemmDesc g8 = g;
      g8.A = (const bf16_t*)(p.ws + OFF_H8); g8.Bt = (const bf16_t*)(p.ws + OFF_W8); g8.lda = 1024; g8.ldb = 1024; g8.N = 8192; g8.K = 1024;
      if (l == 1) g8.M = TL;
      g8.epi = E_GATE8; g8.obf = (bf16_t*)(p.ws + OFF_COLS) + C_GATE; g8.ldo = NIN; g8.rowscale = (const float*)(p.ws + OFF_SC); g8.colmax = (const float*)(p.ws + OFF_SC) + TT;
      gemm_phase<true>((LAS unsigned char*)smem, g8);
    }
    if constexpr (k == 1 && l == 0) { phase_convert(p, 0, smem, CVT_IN, CVT_FF2_LO, 128);
                                      phase_convert(p, 0, smem, CVT_FF2_HI, CVT_TOT, 128); }
    if constexpr (k == 7 && l == 0) phase_colmax(p, 1, smem, 128);
    if constexpr (k == 7 && l == 0) phase_mod(p, smem, 1, 2, 32);
    if constexpr (k == 6 && l == 0) phase_convert(p, 0, smem, CVT_FF2_LO, CVT_FF2_HI, 32);
    if constexpr (k == 10 && l == 0) { phase_convert(p, 1, smem, 0, CVT_FF2_LO, 32);
                                       phase_convert(p, 1, smem, CVT_FF2_HI, CVT_TOT, 32); }
    if constexpr (k == 1 && l == 1) phase_convert(p, 1, smem, CVT_FF2_LO, CVT_FF2_HI, 180);
  }
}

__global__ void __launch_bounds__(512, 2) fwd_megakernel(Params p) {
  extern __shared__ __attribute__((aligned(16))) unsigned char smem[];
  cg::grid_group grid = cg::this_grid();
  if (threadIdx.x < 4) ((volatile LAS unsigned*)(smem + kPhaseLds))[threadIdx.x] = 0u;
  __syncthreads();
  (void)xcd_barrier_post((unsigned*)(p.ws + OFF_BAR), (volatile LAS unsigned*)(smem + kPhaseLds));
  phase_mod(p, smem, 0, 1, 0);
  phase_colmax(p, 0, smem, 96);
  if (p.ws == nullptr) grid.sync();
  grid_barrier(p, smem);
#define PH(n) do_phase<n>(p, smem); grid_barrier(p, smem);
  PH(0) PH(1) PH(2) PH(3) PH(4) PH(5) PH(6) PH(7) PH(8) PH(9) PH(10)
  PH(11) PH(12) PH(13) PH(14) PH(15) PH(16) PH(17) PH(18) PH(19) PH(20) PH(21)
#undef PH
  phase_final_norm(p.out, p.in[31]);
}

extern "C" void kernel_launch(void* const* d_in, const int* in_sizes, int n_in, void* d_out, int out_size,
                              void* d_ws, size_t ws_size, hipStream_t stream) {
  static int grid_blocks = 0;
  if (!grid_blocks) {
    int dev = 0, cus = 0, per_cu = 0;
    (void)hipGetDevice(&dev);
    (void)hipDeviceGetAttribute(&cus, hipDeviceAttributeMultiprocessorCount, dev);
    (void)hipFuncSetAttribute((const void*)fwd_megakernel, hipFuncAttributeMaxDynamicSharedMemorySize, kDynLds);
    (void)hipOccupancyMaxActiveBlocksPerMultiprocessor(&per_cu, fwd_megakernel, 512, kDynLds);
    if (per_cu < 1) per_cu = 1;
    grid_blocks = cus * per_cu;
    if (grid_blocks > 256) grid_blocks = 256;
  }
  if (ws_size < WS_TOTAL) fprintf(stderr, "workspace too small: %zu < %zu\n", ws_size, (size_t)WS_TOTAL);
  Params p{};
  for (int i = 0; i < 32; ++i) p.in[i] = (const float*)d_in[i];
  p.out = (float*)d_out; p.ws = (unsigned char*)d_ws;
  (void)hipMemsetAsync((unsigned char*)d_ws + OFF_BAR, 0, XCD_BAR_WORDS * 4, stream);
  void* args[] = {&p};
  hipError_t e = hipLaunchCooperativeKernel((void*)fwd_megakernel, dim3(grid_blocks), dim3(512), args, kDynLds, stream);
  if (e != hipSuccess) fprintf(stderr, "cooperative launch failed: %s (grid %d)\n", hipGetErrorString(e), grid_blocks);
}
```

```cpp
#include <hip/hip_runtime.h>
#include <hip/hip_cooperative_groups.h>
#include <cstdio>
namespace cg = cooperative_groups;

#define LAS __attribute__((address_space(3)))
typedef unsigned short bf16_t;
typedef short bf16x8 __attribute__((ext_vector_type(8)));
typedef float f32x4 __attribute__((ext_vector_type(4)));
typedef unsigned u32x4 __attribute__((ext_vector_type(4)));
typedef unsigned u32x2 __attribute__((ext_vector_type(2)));

constexpr int DM = 2048, TL = 16384, TC = 1024, TT = 17408, NIN = 15376, NINP = 15616, NMOD = 12288;
constexpr int C_HQ = 0, C_HF = 512, C_HV = 1536, C_HG = 2048, C_RQ = 2560, C_RK = 3072, C_RV = 3584, C_RG = 4096, C_SU = 4608,
              C_MQK = 5120, C_MV = 6144, C_MZ = 6656, C_MG = 7168, C_GATE = 7184;
constexpr size_t al256(size_t x) { return (x + 255) & ~(size_t)255; }
constexpr size_t OFF_WIN = 0;
constexpr size_t OFF_WFF1 = OFF_WIN + al256((size_t)NINP * 2048 * 2);
constexpr size_t OFF_WFF2 = OFF_WFF1 + al256((size_t)8192 * 2048 * 2);
constexpr size_t OFF_WOUT = OFF_WFF2 + al256((size_t)8192 * 2048 * 2);
constexpr size_t OFF_WBR = OFF_WOUT + al256((size_t)2048 * 2048 * 2);
constexpr size_t OFF_WGLU = OFF_WBR + al256((size_t)4 * 2048 * 512 * 2);
constexpr size_t OFF_MOD = OFF_WGLU + al256((size_t)512 * 512 * 2);
constexpr size_t OFF_ACT = OFF_MOD + al256((size_t)2 * 5 * NMOD * 4);
constexpr size_t OFF_COLS = OFF_ACT + al256((size_t)TT * 2048 * 2);
constexpr size_t OFF_O = OFF_COLS + al256((size_t)TT * NIN * 2);
constexpr size_t OFF_YC = OFF_O + al256((size_t)TT * 2048 * 2);
constexpr size_t OFF_RAW = OFF_YC + al256((size_t)TT * 512 * 2);
constexpr size_t OFF_XC = OFF_RAW + al256((size_t)8 * TT * 512 * 2);
constexpr size_t WS_NEED = OFF_XC + al256((size_t)TC * 2048 * 4);
constexpr size_t OFF_BAR = WS_NEED;
constexpr size_t WS_TOTAL = WS_NEED + 16384 + 262144;
constexpr size_t OFF_W8 = OFF_WIN + (size_t)7424 * 2048 * 2;
constexpr size_t OFF_H8 = OFF_O;
constexpr size_t OFF_SC = WS_NEED + 16384;
constexpr size_t OFF_QK = OFF_O;
constexpr size_t OFF_U = OFF_COLS;

constexpr int kPhaseLds = 139264;
constexpr int kDynLds = kPhaseLds + 16;

struct Params {
  const float* in[32];
  float* out;
  unsigned char* ws;
};

__device__ __forceinline__ float bf2f(unsigned b) { return __uint_as_float(b << 16); }
__device__ __forceinline__ float bflo(unsigned w) { return __uint_as_float(w << 16); }
__device__ __forceinline__ float bfhi(unsigned w) { return __uint_as_float(w & 0xffff0000u); }
__device__ __forceinline__ bf16_t f2bf(float f) { unsigned u = __float_as_uint(f); u += 0x7FFFu + ((u >> 16) & 1u); return (bf16_t)(u >> 16); }
typedef __bf16 bf16v2_t __attribute__((ext_vector_type(2)));
typedef float f32x2_t __attribute__((ext_vector_type(2)));
__device__ __forceinline__ unsigned cvt_pk_bf16(float lo, float hi) { f32x2_t v = {lo, hi}; bf16v2_t r = __builtin_convertvector(v, bf16v2_t); return __builtin_bit_cast(unsigned, r); }
__device__ __forceinline__ bf16_t f2bf_hw(float f) { return (bf16_t)(cvt_pk_bf16(f, f) & 0xffffu); }
__device__ __forceinline__ float sigm(float x) { return 1.0f / (1.0f + __expf(-x)); }
__device__ __forceinline__ float siluf(float x) { return x / (1.0f + __expf(-x)); }
__device__ __forceinline__ float wave_sum(float v) {
#pragma unroll
  for (int m = 32; m >= 1; m >>= 1) v += __shfl_xor(v, m);
  return v;
}
template <int CTRL, int ROWMASK> __device__ __forceinline__ float dpp_mov(float identity, float v) {
  return __builtin_bit_cast(float, __builtin_amdgcn_update_dpp(__builtin_bit_cast(int, identity), __builtin_bit_cast(int, v), CTRL, ROWMASK, 0xF, false));
}
__device__ __forceinline__ float wave_scan_add(float v) {
  v += dpp_mov<0x111, 0xF>(0.f, v); v += dpp_mov<0x112, 0xF>(0.f, v); v += dpp_mov<0x114, 0xF>(0.f, v); v += dpp_mov<0x118, 0xF>(0.f, v);
  v += dpp_mov<0x142, 0xA>(0.f, v); v += dpp_mov<0x143, 0xC>(0.f, v); return v;
}
__device__ __forceinline__ float wave_scan_max(float v) {
  const float ninf = -__builtin_inff();
  v = fmaxf(v, dpp_mov<0x111, 0xF>(ninf, v)); v = fmaxf(v, dpp_mov<0x112, 0xF>(ninf, v)); v = fmaxf(v, dpp_mov<0x114, 0xF>(ninf, v)); v = fmaxf(v, dpp_mov<0x118, 0xF>(ninf, v));
  v = fmaxf(v, dpp_mov<0x142, 0xA>(ninf, v)); v = fmaxf(v, dpp_mov<0x143, 0xC>(ninf, v)); return v;
}
__device__ __forceinline__ int otid() { int t = threadIdx.x; asm volatile("" : "+v"(t)); return t; }
__device__ __forceinline__ int seqrow(int s, int b, int dir) {
  if (s < 256) { const int t = dir ? 255 - s : s; return TL + b * 256 + t; }
  int t = s - 256; t = dir ? 4095 - t : t; return b * 4096 + t;
}

namespace pg8 {
constexpr int BM = 256, BK = 64, HALF = 128, HTB = HALF * BK * 2, NXCD = 8, WGM = 4;
__device__ __forceinline__ int lds_byte(int r, int c) { const int st = (r >> 4) * 2 + (c >> 5), rr = r & 15, cc = c & 31, ob = rr * 64 + cc * 2; return st * 1024 + (ob ^ (((ob >> 9) & 1) << 5)); }
__device__ __forceinline__ void stage_rc(int b, int& R, int& C) { const int st = b / 1024, sb = b % 1024, swz = sb ^ (((sb >> 9) & 1) << 5); R = (st >> 1) * 16 + swz / 64; C = (st & 1) * 32 + (swz % 64) / 2; }
__device__ __forceinline__ int perm32(int rho) { const int n = rho >> 4, i = rho & 15; return 8 * (i >> 2) + 4 * n + (i & 3); }
struct Unit { int pm, pn, kz; };
}

enum { E_COLS = 0, E_GLU = 1, E_MERGE = 2, E_RES = 3, E_RELU2 = 4, E_GATE8 = 5 };
typedef int i32x4 __attribute__((ext_vector_type(4)));
struct GemmDesc {
  const bf16_t* A; const bf16_t* Bt; int lda, ldb, M, N, K, nkz; size_t kzA, kzB;
  int epi;
  bf16_t* obf; int ldo; int ncols;
  const bf16_t* gsrc; const float* bias;
  const float* xin_lat; const float* xin_ctx; float* xout_lat; float* xout_ctx; const float* mod; int moff;
  const float* rowscale; const float* colmax;
};

struct TileOrder {
  int nM, nN, nwg, G, c, nkz;
  __device__ bool next(int i, pg8::Unit& u) const {
    using namespace pg8;
    const int r = (nkz == 4) ? (i >> 2) : i; u.kz = (nkz == 4) ? (i & 3) : 0;
    const long L = (long)r * G + c; if (L >= nwg) return false;
    int wgid = (int)L; { const int q = nwg / NXCD, rr = nwg % NXCD, xcd = wgid % NXCD, off = wgid / NXCD; wgid = (xcd < rr ? xcd * (q + 1) : rr * (q + 1) + (xcd - rr) * q) + off; }
    const int nig = WGM * nN, gid = wgid / nig, fm = gid * WGM, gsz = (nM - fm) < WGM ? (nM - fm) : WGM;
    u.pm = fm + ((wgid % nig) % gsz); u.pn = (wgid % nig) / gsz; return true;
  }
};

__device__ __forceinline__ bool gemm_epilogue(const GemmDesc& g, f32x4 (&acc)[2][2][4][2], const pg8::Unit& u, int wr, int wc, int fr, int fq) {
  const int row0 = u.pm * 256 + wr * 64 + fr;
  const int col0 = u.pn * 256 + wc * 32 + 8 * fq;
  if (g.epi == E_COLS || g.epi == E_RELU2) {
    const bool relu2 = (g.epi == E_RELU2);
    const bool dosilu = (g.epi == E_COLS) && (u.pn < 2);
#pragma unroll
    for (int ai = 0; ai < 2; ++ai)
#pragma unroll
      for (int m = 0; m < 4; ++m) {
        bf16_t* rowp = g.obf + (size_t)(row0 + ai * 128 + m * 16) * g.ldo + col0;
#pragma unroll
        for (int bj = 0; bj < 2; ++bj) {
          f32x4 v0 = acc[ai][bj][m][0], v1 = acc[ai][bj][m][1];
          if (relu2) {
#pragma unroll
            for (int j = 0; j < 4; ++j) { float a = fmaxf(v0[j], 0.f), b = fmaxf(v1[j], 0.f); v0[j] = a * a; v1[j] = b * b; }
          }
          if (dosilu) {
#pragma unroll
            for (int j = 0; j < 4; ++j) { v0[j] = v0[j] * __builtin_amdgcn_rcpf(1.0f + __expf(-v0[j])); v1[j] = v1[j] * __builtin_amdgcn_rcpf(1.0f + __expf(-v1[j])); }
          }
          u32x4 w; w.x = cvt_pk_bf16(v0[0], v0[1]); w.y = cvt_pk_bf16(v0[2], v0[3]); w.z = cvt_pk_bf16(v1[0], v1[1]); w.w = cvt_pk_bf16(v1[2], v1[3]);
          if (col0 + bj * 128 < g.ncols) *(u32x4*)(rowp + bj * 128) = w;
        }
      }
    return false;
  }
  if (g.epi == E_GATE8) {
#pragma unroll
    for (int bj = 0; bj < 2; ++bj) {
      const f32x4 w0 = *(const f32x4*)(g.colmax + col0 + bj * 128) * (1.0f / 127.0f), w1 = *(const f32x4*)(g.colmax + col0 + bj * 128 + 4) * (1.0f / 127.0f);
#pragma unroll
      for (int ai = 0; ai < 2; ++ai)
#pragma unroll
        for (int m = 0; m < 4; ++m) {
          const size_t row = (size_t)(row0 + ai * 128 + m * 16);
          const float rs = g.rowscale[row];
          const i32x4 a0 = __builtin_bit_cast(i32x4, acc[ai][bj][m][0]), a1 = __builtin_bit_cast(i32x4, acc[ai][bj][m][1]);
          u32x4 w;
          w.x = cvt_pk_bf16((float)a0[0] * rs * w0[0], (float)a0[1] * rs * w0[1]); w.y = cvt_pk_bf16((float)a0[2] * rs * w0[2], (float)a0[3] * rs * w0[3]);
          w.z = cvt_pk_bf16((float)a1[0] * rs * w1[0], (float)a1[1] * rs * w1[1]); w.w = cvt_pk_bf16((float)a1[2] * rs * w1[2], (float)a1[3] * rs * w1[3]);
          *(u32x4*)(g.obf + row * g.ldo + col0 + bj * 128) = w;
        }
    }
    return false;
  }
  if (g.epi == E_GLU) {
#pragma unroll
    for (int bj = 0; bj < 2; ++bj) {
      const f32x4 b0 = *(const f32x4*)(g.bias + col0 + bj * 128), b1 = *(const f32x4*)(g.bias + col0 + bj * 128 + 4);
#pragma unroll
      for (int ai = 0; ai < 2; ++ai)
#pragma unroll
        for (int m = 0; m < 4; ++m) {
          const size_t row = (size_t)(row0 + ai * 128 + m * 16);
          const u32x4 y = *(const u32x4*)(g.gsrc + row * 512 + col0 + bj * 128);
          const f32x4 v0 = acc[ai][bj][m][0] + b0, v1 = acc[ai][bj][m][1] + b1;
          u32x4 w;
          w.x = cvt_pk_bf16(bflo(y.x) * sigm(v0[0]), bfhi(y.x) * sigm(v0[1]));
          w.y = cvt_pk_bf16(bflo(y.y) * sigm(v0[2]), bfhi(y.y) * sigm(v0[3]));
          w.z = cvt_pk_bf16(bflo(y.z) * sigm(v1[0]), bfhi(y.z) * sigm(v1[1]));
          w.w = cvt_pk_bf16(bflo(y.w) * sigm(v1[2]), bfhi(y.w) * sigm(v1[3]));
          *(u32x4*)(g.obf + row * g.ldo + col0 + bj * 128) = w;
        }
    }
    return false;
  }
  if (g.epi == E_MERGE) {
    const int kz = u.kz;
    const bool lastz = (kz == 3);
#pragma unroll
    for (int ai = 0; ai < 2; ++ai)
#pragma unroll
      for (int m = 0; m < 4; ++m) {
        const size_t row = (size_t)(row0 + ai * 128 + m * 16);
        const bf16_t* gp = g.gsrc + row * NIN + C_GATE + kz * 2048 + col0;
#pragma unroll
        for (int bj = 0; bj < 2; ++bj) {
          unsigned wout[4];
#pragma unroll
          for (int n = 0; n < 2; ++n) {
            const u32x2 ga = *(const u32x2*)(gp + bj * 128 + n * 4);
            const float ea[4] = {bflo(ga.x), bfhi(ga.x), bflo(ga.y), bfhi(ga.y)};
            f32x4 v = acc[ai][bj][m][n];
            if (!lastz) {
              const u32x2 gb = *(const u32x2*)(gp + 2048 + bj * 128 + n * 4);
              const float eb[4] = {bflo(gb.x), bfhi(gb.x), bflo(gb.y), bfhi(gb.y)};
#pragma unroll
              for (int j = 0; j < 4; ++j) v[j] *= (1.0f + __expf(-eb[j])) * __builtin_amdgcn_rcpf(1.0f + __expf(-ea[j]));
              acc[ai][bj][m][n] = v;
            } else {
#pragma unroll
              for (int j = 0; j < 4; ++j) v[j] *= __builtin_amdgcn_rcpf(1.0f + __expf(-ea[j]));
              wout[n * 2] = cvt_pk_bf16(v[0], v[1]); wout[n * 2 + 1] = cvt_pk_bf16(v[2], v[3]);
            }
          }
          if (lastz) { u32x4 w; w.x = wout[0]; w.y = wout[1]; w.z = wout[2]; w.w = wout[3]; *(u32x4*)(g.obf + row * g.ldo + col0 + bj * 128) = w; }
        }
        __builtin_amdgcn_sched_barrier(0);
      }
    return !lastz;
  }
  {
    const bool isctx = (u.pm >= 64);
    const float* xin = isctx ? g.xin_ctx - (size_t)TL * 2048 : g.xin_lat;
    float* xout = isctx ? g.xout_ctx - (size_t)TL * 2048 : g.xout_lat;
    const float* mp = g.mod + (size_t)(isctx ? 4 : (u.pm >> 4)) * NMOD + g.moff + col0;
#pragma unroll
    for (int bj = 0; bj < 2; ++bj) {
      const f32x4 m0 = *(const f32x4*)(mp + bj * 128), m1 = *(const f32x4*)(mp + bj * 128 + 4);
#pragma unroll
      for (int ai = 0; ai < 2; ++ai)
#pragma unroll
        for (int m = 0; m < 4; ++m) {
          const size_t off = (size_t)(row0 + ai * 128 + m * 16) * 2048 + col0 + bj * 128;
          const f32x4 x0 = *(const f32x4*)(xin + off), x1 = *(const f32x4*)(xin + off + 4);
          *(f32x4*)(xout + off) = x0 + m0 * acc[ai][bj][m][0];
          *(f32x4*)(xout + off + 4) = x1 + m1 * acc[ai][bj][m][1];
        }
    }
    return false;
  }
}

template <bool I8 = false>
__device__ __forceinline__ void gemm_phase(LAS unsigned char* lds, const GemmDesc& g) {
  using namespace pg8;
  const int tid = otid(), wid = __builtin_amdgcn_readfirstlane(tid >> 6), lane = tid & 63, wr = wid >> 2, wc = wid & 3, fr = lane & 15, fq = lane >> 4;
  const int K = g.K, nt = K / BK;
  TileOrder S; S.nM = g.M / BM; S.nN = g.N / BM; S.nwg = S.nM * S.nN; S.G = (int)gridDim.x; S.c = (int)blockIdx.x; S.nkz = g.nkz;
  unsigned voffA[2], voffB[2];
#pragma unroll
  for (int i = 0; i < 2; ++i) { int R, C; stage_rc(tid * 16 + i * 8192, R, C); const int Rb = (R & ~31) + perm32(R & 31);
    voffA[i] = (unsigned)(R * g.lda + C) * 2u; voffB[i] = (unsigned)(Rb * g.ldb + C) * 2u; }
  const size_t kstep = (size_t)(BK * 2);
  const size_t hstepA = (size_t)HALF * g.lda * 2, hstepB = (size_t)HALF * g.ldb * 2;
  const size_t tstepA = 2 * hstepA, tstepB = 2 * hstepB;
  const unsigned ldsw = (unsigned)wid * 1024u;
  const int aoff = lds_byte(wr * 64 + fr, fq * 8), boff = lds_byte(wc * 32 + fr, fq * 8);
#define PG8_SA(b, h) (((b) * 2 + (h)) * HTB)
#define PG8_SB(b, h) ((4 + (b) * 2 + (h)) * HTB)
#define PG8_STAGE(bufoff, gbase, voff) do { _Pragma("unroll") for (int _i = 0; _i < 2; ++_i) \
        __builtin_amdgcn_global_load_lds((const unsigned*)((const char*)(gbase) + (voff)[_i]), (LAS unsigned*)(lds + (bufoff) + ldsw + _i * 8192), 16, 0, 0); } while (0)
#define PG8_LDA(dst, b, h) do { _Pragma("unroll") for (int m = 0; m < 4; ++m) _Pragma("unroll") for (int k = 0; k < 2; ++k) dst[m][k] = *(const LAS bf16x8*)(lds + PG8_SA(b, h) + aoff + m * 2048 + k * 1024); } while (0)
#define PG8_LDB(dst, b, h) do { _Pragma("unroll") for (int n = 0; n < 2; ++n) _Pragma("unroll") for (int k = 0; k < 2; ++k) dst[n][k] = *(const LAS bf16x8*)(lds + PG8_SB(b, h) + boff + n * 2048 + k * 1024); } while (0)
#define PG8_MMA(ai, bj, At, Bt) do { __builtin_amdgcn_s_setprio(1); _Pragma("unroll") for (int m = 0; m < 4; ++m) _Pragma("unroll") for (int n = 0; n < 2; ++n) _Pragma("unroll") for (int k = 0; k < 2; ++k) \
        { if constexpr (I8) acc[ai][bj][m][n] = __builtin_bit_cast(f32x4, __builtin_amdgcn_mfma_i32_16x16x64_i8(__builtin_bit_cast(i32x4, Bt[n][k]), __builtin_bit_cast(i32x4, At[m][k]), __builtin_bit_cast(i32x4, acc[ai][bj][m][n]), 0, 0, 0)); \
          else acc[ai][bj][m][n] = __builtin_amdgcn_mfma_f32_16x16x32_bf16(Bt[n][k], At[m][k], acc[ai][bj][m][n], 0, 0, 0); } __builtin_amdgcn_s_setprio(0); } while (0)
#define PG8_WAIT_V(n) asm volatile("s_waitcnt vmcnt(" #n ")" ::: "memory")
#define PG8_WAIT_L(n) asm volatile("s_waitcnt lgkmcnt(" #n ")" ::: "memory")
#define PG8_BAR __builtin_amdgcn_s_barrier()
#define PG8_SCHED __builtin_amdgcn_sched_barrier(0)
  Unit cur, nxt; int ui = 0;
  if (!S.next(0, cur)) return;
  f32x4 acc[2][2][4][2];
#pragma unroll
  for (int a = 0; a < 2; ++a)
#pragma unroll
    for (int b = 0; b < 2; ++b)
#pragma unroll
      for (int m = 0; m < 4; ++m)
#pragma unroll
        for (int n = 0; n < 2; ++n) acc[a][b][m][n] = (f32x4){0.f, 0.f, 0.f, 0.f};
  bf16x8 At[4][2], B0[2][2], B1[2][2];
  const char* cA = (const char*)g.A + (size_t)cur.pm * tstepA + (size_t)cur.kz * g.kzA;
  const char* cB = (const char*)g.Bt + (size_t)cur.pn * tstepB + (size_t)cur.kz * g.kzB;
  PG8_STAGE(PG8_SB(0, 0), cB, voffB); PG8_STAGE(PG8_SA(0, 0), cA, voffA); PG8_STAGE(PG8_SB(0, 1), cB + hstepB, voffB); PG8_STAGE(PG8_SA(0, 1), cA + hstepA, voffA);
  if (wr == 1) PG8_BAR;
  PG8_WAIT_V(4); PG8_BAR;
  PG8_STAGE(PG8_SB(1, 0), cB + kstep, voffB); PG8_STAGE(PG8_SA(1, 0), cA + kstep, voffA); PG8_STAGE(PG8_SB(1, 1), cB + hstepB + kstep, voffB);
  PG8_WAIT_V(6); PG8_BAR;
  for (;;) {
    const bool has_next = S.next(ui + 1, nxt);
    const char* nA = has_next ? (const char*)g.A + (size_t)nxt.pm * tstepA + (size_t)nxt.kz * g.kzA : cA;
    const char* nB = has_next ? (const char*)g.Bt + (size_t)nxt.pn * tstepB + (size_t)nxt.kz * g.kzB : cB;
    for (int t = 0; t < nt; t += 2) {
      const bool last = (t == nt - 2);
      const char* a1 = cA + (size_t)(t + 1) * kstep;
      const char* a2 = last ? nA : cA + (size_t)(t + 2) * kstep; const char* b2 = last ? nB : cB + (size_t)(t + 2) * kstep;
      const char* a3 = a2 + kstep; const char* b3 = b2 + kstep;
      PG8_LDB(B0, 0, 0); PG8_SCHED; PG8_LDA(At, 0, 0); PG8_STAGE(PG8_SA(1, 1), a1 + hstepA, voffA);
      PG8_WAIT_L(8); PG8_BAR; PG8_WAIT_L(0); PG8_MMA(0, 0, At, B0); PG8_BAR; PG8_SCHED;
      PG8_LDB(B1, 0, 1); PG8_STAGE(PG8_SB(0, 0), b2, voffB);
      PG8_BAR; PG8_WAIT_L(0); PG8_MMA(0, 1, At, B1); PG8_BAR;
      PG8_LDA(At, 0, 1); PG8_STAGE(PG8_SA(0, 0), a2, voffA);
      PG8_BAR; PG8_WAIT_L(0); PG8_MMA(1, 0, At, B0); PG8_BAR; PG8_SCHED;
      PG8_STAGE(PG8_SB(0, 1), b2 + hstepB, voffB);
      PG8_WAIT_V(6); PG8_BAR; PG8_MMA(1, 1, At, B1); PG8_BAR;
      PG8_LDB(B0, 1, 0); PG8_SCHED; PG8_LDA(At, 1, 0); PG8_STAGE(PG8_SA(0, 1), a2 + hstepA, voffA);
      PG8_WAIT_L(8); PG8_BAR; PG8_WAIT_L(0); PG8_MMA(0, 0, At, B0); PG8_BAR; PG8_SCHED;
      PG8_LDB(B1, 1, 1); PG8_STAGE(PG8_SB(1, 0), b3, voffB);
      PG8_BAR; PG8_WAIT_L(0); PG8_MMA(0, 1, At, B1); PG8_BAR;
      PG8_LDA(At, 1, 1); PG8_STAGE(PG8_SA(1, 0), a3, voffA);
      PG8_BAR; PG8_WAIT_L(0); PG8_MMA(1, 0, At, B0); PG8_BAR; PG8_SCHED;
      PG8_STAGE(PG8_SB(1, 1), b3 + hstepB, voffB);
      PG8_WAIT_V(6); PG8_BAR; PG8_MMA(1, 1, At, B1); PG8_BAR;
    }
    const bool keep = gemm_epilogue(g, acc, cur, wr, wc, fr, fq);
    if (!has_next) break;
    if (!keep) {
#pragma unroll
      for (int a = 0; a < 2; ++a)
#pragma unroll
        for (int b = 0; b < 2; ++b)
#pragma unroll
          for (int m = 0; m < 4; ++m)
#pragma unroll
            for (int n = 0; n < 2; ++n) acc[a][b][m][n] = (f32x4){0.f, 0.f, 0.f, 0.f};
    }
    cur = nxt; cA = nA; cB = nB; ++ui;
  }
  PG8_WAIT_V(0);
  if (wr == 0) PG8_BAR;
  PG8_BAR;
#undef PG8_SA
#undef PG8_SB
#undef PG8_STAGE
#undef PG8_LDA
#undef PG8_LDB
#undef PG8_MMA
#undef PG8_WAIT_V
#undef PG8_WAIT_L
#undef PG8_BAR
#undef PG8_SCHED
}

__device__ __forceinline__ void phase_mod(const Params& p, unsigned char* smem, int l0, int l1, int first_blk_256) {
  const int first_blk = (gridDim.x == 256u) ? first_blk_256 : 0;
  if ((int)blockIdx.x < first_blk) return;
  float* sv = (float*)smem;
  float* red = sv + 5 * 2048;
  const int tid = otid();
  const float* c = p.in[1]; const float* cctx = p.in[3];
  for (int i = tid; i < 5 * 2048; i += 512) { const int m = i >> 11, k = i & 2047; const float v = m < 4 ? c[m * 2048 + k] : cctx[k]; sv[i] = v / (1.0f + expf(-v)); }
  __syncthreads();
  float* mod = (float*)(p.ws + OFF_MOD);
  for (int item = l0 * 96 + (int)blockIdx.x - first_blk; item < l1 * 96; item += (int)gridDim.x - first_blk) {
    const int l = item / 96, cb = (item % 96) * 128, kg = tid >> 5, c4 = (tid & 31) * 4;
    const float* w = p.in[4] + (size_t)l * 2048 * NMOD + cb + c4;
    f32x4 a0 = (f32x4){0.f, 0.f, 0.f, 0.f}, a1 = a0, a2 = a0, a3 = a0, a4 = a0;
#pragma unroll 16
    for (int k = kg * 128; k < kg * 128 + 128; ++k) {
      const f32x4 wv = *(const f32x4*)(w + (size_t)k * NMOD);
      a0 += sv[k] * wv; a1 += sv[2048 + k] * wv; a2 += sv[4096 + k] * wv; a3 += sv[6144 + k] * wv; a4 += sv[8192 + k] * wv;
    }
    *(f32x4*)(red + (kg * 5 + 0) * 128 + c4) = a0; *(f32x4*)(red + (kg * 5 + 1) * 128 + c4) = a1; *(f32x4*)(red + (kg * 5 + 2) * 128 + c4) = a2;
    *(f32x4*)(red + (kg * 5 + 3) * 128 + c4) = a3; *(f32x4*)(red + (kg * 5 + 4) * 128 + c4) = a4;
    __syncthreads();
    for (int o = tid; o < 5 * 128; o += 512) {
      const int m = o >> 7, col = o & 127;
      float sum = p.in[5][l * NMOD + cb + col];
#pragma unroll
      for (int g2 = 0; g2 < 16; ++g2) sum += red[(g2 * 5 + m) * 128 + col];
      mod[(size_t)(l * 5 + m) * NMOD + cb + col] = sum;
    }
    __syncthreads();
  }
}

__device__ __forceinline__ void phase_colmax(const Params& p, int l, unsigned char* smem, int first_blk_256) {
  const int first_blk = (gridDim.x == 256u) ? first_blk_256 : 0;
  if ((int)blockIdx.x < first_blk) return;
  float* red = (float*)smem;
  float* colmax = (float*)(p.ws + OFF_SC) + TT;
  const int tid = otid(), kg = tid >> 6, col = tid & 63;
  for (int item = (int)blockIdx.x - first_blk; item < 128; item += (int)gridDim.x - first_blk) {
    const float* w = p.in[8] + (size_t)l * 2048 * NIN + C_GATE + item * 64 + col;
    float m = 0.f;
#pragma unroll 16
    for (int k = kg * 256; k < kg * 256 + 256; ++k) m = fmaxf(m, fabsf(w[(size_t)k * NIN]));
    red[kg * 64 + col] = m;
    __syncthreads();
    if (tid < 64) { float mm = red[tid];
#pragma unroll
      for (int g2 = 1; g2 < 8; ++g2) mm = fmaxf(mm, red[g2 * 64 + tid]);
      colmax[item * 64 + tid] = fmaxf(mm, 1e-30f); }
    __syncthreads();
  }
}

struct CvtTile { const float* src; bf16_t* dst; int K, N, k0, n0, is8; };
__device__ __forceinline__ CvtTile cvt_lookup(const Params& p, int l, int t) {
  constexpr int T_IN = 32 * (NINP / 64), T_FF = 4096, T_OUT = 1024, T_BR = 256;
  CvtTile c; int r = t; c.is8 = 0;
  constexpr int T_INB = 32 * (7424 / 64);
  if (r < T_INB) { c.src = p.in[8] + (size_t)l * 2048 * NIN; c.K = 2048; c.N = NIN; c.dst = (bf16_t*)(p.ws + OFF_WIN); }
  else if (r < T_IN) { r -= T_INB; c.is8 = 1; c.src = p.in[8] + (size_t)l * 2048 * NIN + C_GATE; c.K = 2048; c.N = NIN; c.dst = (bf16_t*)(p.ws + OFF_W8); }
  else if ((r -= T_IN) < T_FF) { c.src = p.in[29] + (size_t)l * 2048 * 8192; c.K = 2048; c.N = 8192; c.dst = (bf16_t*)(p.ws + OFF_WFF1); }
  else if ((r -= T_FF) < T_FF) { c.src = p.in[30] + (size_t)l * 8192 * 2048; c.K = 8192; c.N = 2048; c.dst = (bf16_t*)(p.ws + OFF_WFF2); }
  else if ((r -= T_FF) < T_OUT) { c.src = p.in[28] + (size_t)l * 2048 * 2048; c.K = 2048; c.N = 2048; c.dst = (bf16_t*)(p.ws + OFF_WOUT); }
  else if ((r -= T_OUT) < 4 * T_BR) { const int j = r / T_BR; r -= j * T_BR; c.src = p.in[27] + (size_t)(l * 4 + j) * 512 * 2048; c.K = 512; c.N = 2048; c.dst = (bf16_t*)(p.ws + OFF_WBR) + (size_t)j * 2048 * 512; }
  else { r -= 4 * T_BR; c.src = p.in[21] + (size_t)l * 512 * 512; c.K = 512; c.N = 512; c.dst = (bf16_t*)(p.ws + OFF_WGLU); }
  const int nkt = c.K >> 6; c.k0 = (r % nkt) * 64; c.n0 = (r / nkt) * 64;
  return c;
}
constexpr int CVT_IN = 32 * (NINP / 64), CVT_FF2_LO = CVT_IN + 4096, CVT_FF2_HI = CVT_IN + 8192, CVT_TOT = CVT_IN + 2 * 4096 + 1024 + 4 * 256 + 64;
__device__ __forceinline__ void phase_convert(const Params& p, int l, unsigned char* smem, int lo, int hi, int first_blk_256) {
  const int first_blk = (gridDim.x == 256u) ? first_blk_256 : 0;
  bf16_t* tl = (bf16_t*)smem;
  const int TOT = hi;
  const int tid = otid(), G = (int)gridDim.x - first_blk;
  if ((int)blockIdx.x < first_blk) return;
  for (int t0 = lo + (int)blockIdx.x - first_blk; t0 < TOT; t0 += 8 * G) {
    f32x4 v[8][2];
#pragma unroll
    for (int q = 0; q < 8; ++q) {
      const int t = t0 + q * G;
      v[q][0] = (f32x4){0.f, 0.f, 0.f, 0.f}; v[q][1] = v[q][0];
      if (t < TOT) {
        const CvtTile c = cvt_lookup(p, l, t);
#pragma unroll
        for (int ps = 0; ps < 2; ++ps) { const int kk = (tid >> 4) + 32 * ps, n4 = (tid & 15) * 4; if (c.is8 || c.n0 + n4 < c.N) v[q][ps] = *(const f32x4*)(c.src + (size_t)(c.k0 + kk) * c.N + c.n0 + n4);
          if (c.is8) { const f32x4 cm = *(const f32x4*)((const float*)(p.ws + OFF_SC) + TT + c.n0 + n4);
#pragma unroll
            for (int j = 0; j < 4; ++j) v[q][ps][j] = fminf(fmaxf(rintf(v[q][ps][j] * (127.0f / cm[j])), -127.f), 127.f); } }
      }
    }
    const bool grp8 = (t0 < TOT) && cvt_lookup(p, l, t0).is8 && (t0 + 7 * G < CVT_IN) ;
#pragma unroll
    for (int q = 0; q < 8; ++q) {
      const int t = t0 + q * G;
      const bool is8 = (t < TOT) && (t >= 32 * (7424 / 64)) && (t < CVT_IN);
#pragma unroll
      for (int ps = 0; ps < 2; ++ps) { const int kk = (tid >> 4) + 32 * ps, n4 = (tid & 15) * 4;
        if (is8) {
#pragma unroll
          for (int j = 0; j < 4; ++j) ((signed char*)(tl + q * 4608))[(n4 + j) * 80 + kk] = (signed char)(int)v[q][ps][j];
        } else {
#pragma unroll
          for (int j = 0; j < 4; ++j) tl[q * 4608 + (n4 + j) * 72 + kk] = f2bf(v[q][ps][j]);
        } }
    }
    (void)grp8;
    __syncthreads();
#pragma unroll
    for (int q = 0; q < 8; ++q) {
      const int t = t0 + q * G;
      if (t < TOT) { const CvtTile c = cvt_lookup(p, l, t);
        if (c.is8) { if (tid < 256) { const int n = tid >> 2, sg = tid & 3;
            *(u32x4*)((signed char*)c.dst + (size_t)(c.n0 + n) * 2048 + c.k0 + 16 * sg) = *(const u32x4*)((const signed char*)(tl + q * 4608) + n * 80 + 16 * sg); } }
        else { const int n = tid >> 3, k8 = (tid & 7) * 8;
          *(u32x4*)(c.dst + (size_t)(c.n0 + n) * c.K + c.k0 + k8) = *(const u32x4*)(tl + q * 4608 + n * 72 + k8); } }
    }
    __syncthreads();
  }
}

__device__ __forceinline__ void phase_norm(const float* xlat, const float* xctx, int nrows, const float* gw, const float* mod, int soff, bf16_t* dst, signed char* h8 = nullptr, float* rowscale = nullptr) {
  const int tid_ = otid(); const int lane = tid_ & 63, gwv = blockIdx.x * 8 + (tid_ >> 6), nw = gridDim.x * 8;
  for (int row = gwv; row < nrows; row += nw) {
    const float* xr = row < TL ? xlat + (size_t)row * 2048 : xctx + (size_t)(row - TL) * 2048;
    const float* mp = mod + (size_t)(row < TL ? (row >> 12) : 4) * NMOD + soff;
    f32x4 v[8]; float ss = 0.f;
#pragma unroll
    for (int i = 0; i < 8; ++i) { v[i] = *(const f32x4*)(xr + i * 256 + lane * 4); ss += v[i][0] * v[i][0] + v[i][1] * v[i][1] + v[i][2] * v[i][2] + v[i][3] * v[i][3]; }
    ss = wave_sum(ss);
    const float r = rsqrtf(ss * (1.0f / 2048.0f) + 1e-6f);
#pragma unroll
    for (int i = 0; i < 8; ++i) {
      const int c = i * 256 + lane * 4;
      const f32x4 g4 = *(const f32x4*)(gw + c), sh = *(const f32x4*)(mp + c), sc = *(const f32x4*)(mp + 2048 + c);
      f32x4 y;
#pragma unroll
      for (int j = 0; j < 4; ++j) y[j] = v[i][j] * r * g4[j] * (1.0f + sc[j]) + sh[j];
      u32x2 w; w.x = cvt_pk_bf16(y[0], y[1]); w.y = cvt_pk_bf16(y[2], y[3]);
      *(u32x2*)(dst + (size_t)row * 2048 + c) = w;
      v[i] = y;
    }
    if (h8 != nullptr) {
      float mx = 0.f;
#pragma unroll
      for (int i = 0; i < 8; ++i) mx = fmaxf(mx, fmaxf(fmaxf(fabsf(v[i][0]), fabsf(v[i][1])), fmaxf(fabsf(v[i][2]), fabsf(v[i][3]))));
#pragma unroll
      for (int m2 = 32; m2 >= 1; m2 >>= 1) mx = fmaxf(mx, __shfl_xor(mx, m2));
      mx = fmaxf(mx, 1e-30f);
      const float inv = 127.0f / mx;
      if (lane == 0) rowscale[row] = mx * (1.0f / 127.0f);
#pragma unroll
      for (int i = 0; i < 8; ++i) {
        const int c = i * 256 + lane * 4;
        const int q0 = (int)rintf(v[i][0] * inv), q1 = (int)rintf(v[i][1] * inv), q2 = (int)rintf(v[i][2] * inv), q3 = (int)rintf(v[i][3] * inv);
        *(unsigned*)(h8 + (size_t)row * 2048 + c) = (unsigned)(q0 & 255) | ((unsigned)(q1 & 255) << 8) | ((unsigned)(q2 & 255) << 16) | ((unsigned)(q3 & 255) << 24);
      }
    }
  }
}
__device__ __forceinline__ void phase_final_norm(float* x, const float* gw) {
  const int tid_ = otid(); const int lane = tid_ & 63, gwv = blockIdx.x * 8 + (tid_ >> 6), nw = gridDim.x * 8;
  for (int row = gwv; row < TL; row += nw) {
    float* xr = x + (size_t)row * 2048;
    f32x4 v[8]; float ss = 0.f;
#pragma unroll
    for (int i = 0; i < 8; ++i) { v[i] = *(const f32x4*)(xr + i * 256 + lane * 4); ss += v[i][0] * v[i][0] + v[i][1] * v[i][1] + v[i][2] * v[i][2] + v[i][3] * v[i][3]; }
    ss = wave_sum(ss);
    const float r = rsqrtf(ss * (1.0f / 2048.0f) + 1e-6f);
#pragma unroll
    for (int i = 0; i < 8; ++i) { const int c = i * 256 + lane * 4; const f32x4 g4 = *(const f32x4*)(gw + c); *(f32x4*)(xr + c) = v[i] * r * g4; }
  }
}

__device__ __forceinline__ void phase_conv(const Params& p, int l) {
  const bf16_t* cols = (const bf16_t*)(p.ws + OFF_COLS);
  bf16_t* qk = (bf16_t*)(p.ws + OFF_QK);
  const float* cw = p.in[23] + (size_t)l * 9 * 1024; const float* cb = p.in[24] + (size_t)l * 1024;
  const int tid = otid(), c8 = (tid & 127) * 8;
  for (int it = blockIdx.x; it < TT / 4; it += gridDim.x) {
    const int row = it * 4 + (tid >> 7);
    int base, r, cc, R, W;
    if (row < TL) { const int b = row >> 12, t = row & 4095; base = b * 4096; r = t >> 6; cc = t & 63; R = 64; W = 64; }
    else { const int rr = row - TL, b = rr >> 8; base = TL + b * 256; r = 0; cc = rr & 255; R = 1; W = 256; }
    float a[8];
    { const f32x4 b0 = *(const f32x4*)(cb + c8), b1 = *(const f32x4*)(cb + c8 + 4);
#pragma unroll
      for (int j = 0; j < 4; ++j) { a[j] = b0[j]; a[4 + j] = b1[j]; } }
#pragma unroll
    for (int ky = 0; ky < 3; ++ky) {
      const int r2 = r + ky - 1; if (r2 < 0 || r2 >= R) continue;
#pragma unroll
      for (int kx = 0; kx < 3; ++kx) {
        const int c2 = cc + kx - 1; if (c2 < 0 || c2 >= W) continue;
        const u32x4 raw = *(const u32x4*)(cols + (size_t)(base + r2 * W + c2) * NIN + C_MQK + c8);
        const f32x4 w0 = *(const f32x4*)(cw + (ky * 3 + kx) * 1024 + c8), w1 = *(const f32x4*)(cw + (ky * 3 + kx) * 1024 + c8 + 4);
        a[0] += bflo(raw.x) * w0[0]; a[1] += bfhi(raw.x) * w0[1]; a[2] += bflo(raw.y) * w0[2]; a[3] += bfhi(raw.y) * w0[3];
        a[4] += bflo(raw.z) * w1[0]; a[5] += bfhi(raw.z) * w1[1]; a[6] += bflo(raw.w) * w1[2]; a[7] += bfhi(raw.w) * w1[3];
      }
    }
    const float sc = (c8 >= 512) ? 0.08838834764831845f : 1.0f;
#pragma unroll
    for (int j = 0; j < 8; ++j) a[j] = siluf(a[j]) * sc;
    u32x4 w; w.x = cvt_pk_bf16(a[0], a[1]); w.y = cvt_pk_bf16(a[2], a[3]); w.z = cvt_pk_bf16(a[4], a[5]); w.w = cvt_pk_bf16(a[6], a[7]);
    *(u32x4*)(qk + (size_t)row * 1024 + c8) = w;
  }
}

__device__ __forceinline__ void chunk_base(int ci, int b, int dir, int& base, int& sgn) {
  const int start = ci < 4 ? TL + b * 256 + (dir ? 3 - ci : ci) * 64 : b * 4096 + (dir ? 67 - ci : ci - 4) * 64;
  base = dir ? start + 63 : start; sgn = dir ? -1 : 1;
}
__device__ __forceinline__ bf16x8 lds_frag(const bf16_t* p) { return *(const bf16x8*)p; }

template <int KIND  >
__device__ __forceinline__ void scan_matrix_chunk(const Params& p, int l, int b, int h, int dir, int vh, unsigned char* smem) {
  constexpr int NV = (KIND == 3) ? 5 : 4;
  bf16_t* Qa = (bf16_t*)smem;
  bf16_t* Ka = Qa + 64 * 136;
  bf16_t* Qb = Ka + 64 * 136;
  bf16_t* Kt = Qb + 64 * 136;
  bf16_t* Vt = Kt + 128 * 72;
  bf16_t* Pm = Vt + 80 * 72;
  bf16_t* St = Pm + 64 * 72;
  float* segtot = (float*)(St + 80 * 136);
  float* delta = segtot + 1024;
  float* aq = delta + 128; float* clampv = aq + 256; float* dsc = clampv + 64;
  const bf16_t* cols = (const bf16_t*)(p.ws + OFF_COLS);
  const bf16_t* qkb = (const bf16_t*)(p.ws + OFF_QK);
  bf16_t* raw = (bf16_t*)(p.ws + OFF_RAW) + (size_t)(KIND * 2 + dir) * TT * 512 + h * 128 + vh * 64;
  const int tid = otid(), lane = tid & 63, wid = tid >> 6, l15 = lane & 15, lq = lane >> 4;
  const int dp = tid & 63, sg8 = tid >> 6, vcol = tid & 63, s8 = tid >> 6;
  const bf16_t* qsrc; const bf16_t* ksrc; size_t qstr;
  if (KIND == 0) { qsrc = cols + C_HQ + h * 128 + 2 * dp; ksrc = cols + C_HF + dir * 512 + h * 128 + 2 * dp; qstr = NIN; }
  else if (KIND == 1) { qsrc = cols + C_RQ + h * 128 + 2 * dp; ksrc = cols + C_RK + h * 128 + 2 * dp; qstr = NIN; }
  else { qsrc = qkb + h * 128 + 2 * dp; ksrc = qkb + 512 + h * 128 + 2 * dp; qstr = 1024; }
  const bf16_t* vsrc = cols + (KIND == 0 ? C_HV : KIND == 1 ? C_RV : C_MV) + h * 128 + vh * 64 + vcol;
  const bf16_t* gsrc = cols + C_MG + dir * 8 + h;
  float lb0 = 0.f, lb1 = 0.f;
  if (KIND == 0 && l == 1) { const int ch = h * 128 + 2 * dp;
    lb0 = 1.0f / (1.0f + expf(p.in[9][(0 * 2 + dir) * 512 + ch] - p.in[9][(1 * 2 + dir) * 512 + ch]));
    lb1 = 1.0f / (1.0f + expf(p.in[9][(0 * 2 + dir) * 512 + ch + 1] - p.in[9][(1 * 2 + dir) * 512 + ch + 1])); }
  float lg = 0.f;
  if (KIND == 1) lg = log1pf(-expf(p.in[11][(l * 2 + dir) * 4 + h]));
  float gbi = 0.f, gbf = 0.f;
  if (KIND == 3) { gbi = p.in[25][l * 16 + dir * 8 + h]; gbf = p.in[25][l * 16 + dir * 8 + 4 + h]; }
  for (int i = tid; i < 80 * 136 / 2; i += 512) ((unsigned*)St)[i] = 0u;
  for (int i = tid; i < 16 * 72 / 2; i += 512) ((unsigned*)(Vt + 64 * 72))[i] = (KIND == 3) ? 0x3F803F80u : 0u;
  f32x4 accS[NV];
#pragma unroll
  for (int i = 0; i < NV; ++i) accS[i] = (f32x4){0.f, 0.f, 0.f, 0.f};
  float mprev = 0.f;
  const bool wctx = (l == 0);
  unsigned rq[8], rk[8]; unsigned short rv[8]; unsigned short rgi = 0, rgf = 0;
  int base, sgn;
  chunk_base(0, b, dir, base, sgn);
#pragma unroll
  for (int i = 0; i < 8; ++i) { const size_t row = (size_t)(base + sgn * (8 * sg8 + i)); rq[i] = *(const unsigned*)(qsrc + row * qstr); rk[i] = *(const unsigned*)(ksrc + row * qstr); }
#pragma unroll
  for (int i = 0; i < 8; ++i) rv[i] = vsrc[(size_t)(base + sgn * (8 * s8 + i)) * NIN];
  if (KIND == 3 && wid == 0) { const size_t row = (size_t)(base + sgn * lane); rgi = gsrc[row * NIN]; rgf = gsrc[row * NIN + 4]; }
  __syncthreads();
  for (int ci = 0; ci < 68; ++ci) {
    const int cbase = base, csgn = sgn;
    if (KIND == 3) {
      if (wid == 0) {
        const float gi = bf2f(rgi) + gbi, gfv = bf2f(rgf) + gbf;
        const float cum = wave_scan_add(fminf(gfv, 0.f) - __logf(1.0f + __expf(-fabsf(gfv))));
        const float e = gi - cum;
        const float a = wave_scan_max(e);
        const float mx = fmaxf(mprev, a);
        const float mx63 = __builtin_bit_cast(float, __builtin_amdgcn_readlane(__builtin_bit_cast(int, mx), 63)), cum63 = __builtin_bit_cast(float, __builtin_amdgcn_readlane(__builtin_bit_cast(int, cum), 63));
        *(f32x4*)(aq + 4 * lane) = (f32x4){__expf(-mx), __expf(e), __expf(mprev - mx), __expf(e - mx63)}; clampv[lane] = __expf(-cum - mx);
        if (lane == 0) dsc[0] = __expf(mprev - mx63);
        mprev = cum63 + mx63;
      }
      __syncthreads();
    }
    {
      float kb0[8], kb1[8];
      if (KIND == 0) {
        const f32x2_t lb = {lb0, lb1}, oml = 1.0f - lb;
        f32x2_t c[8], kk[8]; f32x2_t run = {1.f, 1.f};
#pragma unroll
        for (int i = 0; i < 8; ++i) {
          const f32x2_t z = {bflo(rk[i]), bfhi(rk[i])}, zs = z * (-1.4426950408889634f);
          const f32x2_t ez = {__builtin_amdgcn_exp2f(zs.x), __builtin_amdgcn_exp2f(zs.y)}, dn = 1.0f + ez;
          const f32x2_t sg = {__builtin_amdgcn_rcpf(dn.x), __builtin_amdgcn_rcpf(dn.y)};
          const f32x2_t f = __builtin_elementwise_max(lb + oml * sg, (f32x2_t){1e-30f, 1e-30f});
          run *= f; c[i] = run; kk[i] = oml * ez * sg;
        }
        *(f32x2_t*)(segtot + sg8 * 128 + 2 * dp) = run;
        __syncthreads();
        f32x2_t off = {1.f, 1.f}, mid = {1.f, 1.f}, tail = {1.f, 1.f};
#pragma unroll
        for (int j = 0; j < 8; ++j) {
          const f32x2_t a = *(const f32x2_t*)(segtot + j * 128 + 2 * dp);
          if (j < sg8) off *= a;
          if (j < 4) mid *= a;
          tail *= a;
        }
        const f32x2_t rmid = {__builtin_amdgcn_rcpf(fmaxf(mid.x, 1e-37f)), __builtin_amdgcn_rcpf(fmaxf(mid.y, 1e-37f))};
        if (sg8 == 0) *(f32x2_t*)(delta + 2 * dp) = tail;
#pragma unroll
        for (int i = 0; i < 8; ++i) {
          const int t = 8 * sg8 + i;
          const f32x2_t q = {bflo(rq[i]), bfhi(rq[i])};
          const f32x2_t cp = __builtin_elementwise_max(c[i] * off, (f32x2_t){1e-37f, 1e-37f});
          const f32x2_t rc = {__builtin_amdgcn_rcpf(cp.x), __builtin_amdgcn_rcpf(cp.y)};
          const f32x2_t qc = q * cp, qa = qc * rmid, krc = kk[i] * rc, ka = krc * mid, kb = krc * tail;
          *(unsigned*)(Qa + t * 136 + 2 * dp) = cvt_pk_bf16(qa.x, qa.y);
          *(unsigned*)(Ka + t * 136 + 2 * dp) = cvt_pk_bf16(ka.x, ka.y);
          *(unsigned*)(Qb + t * 136 + 2 * dp) = cvt_pk_bf16(qc.x, qc.y);
          kb0[i] = kb.x; kb1[i] = kb.y;
        }
      } else if (KIND == 1) {
        const float gstep = __expf(lg), g63 = __expf(lg * 63.0f);
        float ga = __expf(lg * (float)(8 * sg8));
#pragma unroll
        for (int i = 0; i < 8; ++i) {
          const int t = 8 * sg8 + i;
          const float q0 = bflo(rq[i]), q1 = bfhi(rq[i]), k0 = bflo(rk[i]) * 0.08838834764831845f, k1 = bfhi(rk[i]) * 0.08838834764831845f;
          const float rga = __builtin_amdgcn_rcpf(ga);
          *(unsigned*)(Qa + t * 136 + 2 * dp) = cvt_pk_bf16(q0 * ga, q1 * ga);
          *(unsigned*)(Ka + t * 136 + 2 * dp) = cvt_pk_bf16(k0 * rga, k1 * rga);
          *(unsigned*)(Qb + t * 136 + 2 * dp) = cvt_pk_bf16(q0 * ga * gstep, q1 * ga * gstep);
          kb0[i] = k0 * g63 * rga; kb1[i] = k1 * g63 * rga;
          ga *= gstep;
        }
      } else {
#pragma unroll
        for (int i = 0; i < 8; ++i) {
          const int t = 8 * sg8 + i;
          const f32x4 sc = *(const f32x4*)(aq + 4 * t);
          const float q0 = bflo(rq[i]), q1 = bfhi(rq[i]), k0 = bflo(rk[i]), k1 = bfhi(rk[i]);
          *(unsigned*)(Qa + t * 136 + 2 * dp) = cvt_pk_bf16(q0 * sc[0], q1 * sc[0]);
          *(unsigned*)(Ka + t * 136 + 2 * dp) = cvt_pk_bf16(k0 * sc[1], k1 * sc[1]);
          *(unsigned*)(Qb + t * 136 + 2 * dp) = cvt_pk_bf16(q0 * sc[2], q1 * sc[2]);
          kb0[i] = k0 * sc[3]; kb1[i] = k1 * sc[3];
        }
      }
      u32x4 w0, w1;
      w0.x = cvt_pk_bf16(kb0[0], kb0[1]); w0.y = cvt_pk_bf16(kb0[2], kb0[3]); w0.z = cvt_pk_bf16(kb0[4], kb0[5]); w0.w = cvt_pk_bf16(kb0[6], kb0[7]);
      w1.x = cvt_pk_bf16(kb1[0], kb1[1]); w1.y = cvt_pk_bf16(kb1[2], kb1[3]); w1.z = cvt_pk_bf16(kb1[4], kb1[5]); w1.w = cvt_pk_bf16(kb1[6], kb1[7]);
      *(u32x4*)(Kt + (2 * dp) * 72 + 8 * sg8) = w0; *(u32x4*)(Kt + (2 * dp + 1) * 72 + 8 * sg8) = w1;
      u32x4 wv; wv.x = (unsigned)rv[0] | ((unsigned)rv[1] << 16); wv.y = (unsigned)rv[2] | ((unsigned)rv[3] << 16);
      wv.z = (unsigned)rv[4] | ((unsigned)rv[5] << 16); wv.w = (unsigned)rv[6] | ((unsigned)rv[7] << 16);
      *(u32x4*)(Vt + vcol * 72 + 8 * s8) = wv;
    }
    if (ci + 1 < 68) {
      chunk_base(ci + 1, b, dir, base, sgn);
#pragma unroll
      for (int i = 0; i < 8; ++i) { const size_t row = (size_t)(base + sgn * (8 * sg8 + i)); rq[i] = *(const unsigned*)(qsrc + row * qstr); rk[i] = *(const unsigned*)(ksrc + row * qstr); }
#pragma unroll
      for (int i = 0; i < 8; ++i) rv[i] = vsrc[(size_t)(base + sgn * (8 * s8 + i)) * NIN];
      if (KIND == 3 && wid == 0) { const size_t row = (size_t)(base + sgn * lane); rgi = gsrc[row * NIN]; rgf = gsrc[row * NIN + 4]; }
    }
    __syncthreads();
    const bool need_out = wctx || ci >= 4;
    if (need_out) {
      const int tm = wid >> 1, tn0 = (wid & 1) * 2;
      bf16x8 af[4];
#pragma unroll
      for (int kd = 0; kd < 4; ++kd) af[kd] = lds_frag(Qa + (16 * tm + l15) * 136 + 32 * kd + 8 * lq);
#pragma unroll
      for (int tt = 0; tt < 2; ++tt) {
        const int tn = tn0 + tt;
        f32x4 acc = (f32x4){0.f, 0.f, 0.f, 0.f};
#pragma unroll
        for (int kd = 0; kd < 4; ++kd) acc = __builtin_amdgcn_mfma_f32_16x16x32_bf16(af[kd], lds_frag(Ka + (16 * tn + l15) * 136 + 32 * kd + 8 * lq), acc, 0, 0, 0);
#pragma unroll
        for (int j = 0; j < 4; ++j) { const int t = 16 * tm + 4 * lq + j, s = 16 * tn + l15; Pm[t * 72 + s] = f2bf_hw(t >= s ? acc[j] : 0.f); }
      }
    }
    __syncthreads();
    {
      const int tm = wid >> 1, tv0 = (wid & 1) * 2;
      bf16x8 aP[2], aQ[4];
#pragma unroll
      for (int ks = 0; ks < 2; ++ks) aP[ks] = lds_frag(Pm + (16 * tm + l15) * 72 + 32 * ks + 8 * lq);
#pragma unroll
      for (int kd = 0; kd < 4; ++kd) aQ[kd] = lds_frag(Qb + (16 * tm + l15) * 136 + 32 * kd + 8 * lq);
      f32x4 den = (f32x4){1.f, 1.f, 1.f, 1.f};
      if (KIND == 3 && need_out) {
        f32x4 acc = (f32x4){0.f, 0.f, 0.f, 0.f};
#pragma unroll
        for (int ks = 0; ks < 2; ++ks) acc = __builtin_amdgcn_mfma_f32_16x16x32_bf16(aP[ks], lds_frag(Vt + (64 + l15) * 72 + 32 * ks + 8 * lq), acc, 0, 0, 0);
#pragma unroll
        for (int kd = 0; kd < 4; ++kd) acc = __builtin_amdgcn_mfma_f32_16x16x32_bf16(aQ[kd], lds_frag(St + (64 + l15) * 136 + 32 * kd + 8 * lq), acc, 0, 0, 0);
        const f32x4 cl = *(const f32x4*)(clampv + 16 * tm + 4 * lq);
#pragma unroll
        for (int j = 0; j < 4; ++j) den[j] = 1.0f / fmaxf(fabsf(acc[j]), cl[j]);
      }
      const bool wr_out = need_out;
      if (need_out)
#pragma unroll
      for (int tt = 0; tt < 2; ++tt) {
        const int tv = tv0 + tt;
        f32x4 acc = (f32x4){0.f, 0.f, 0.f, 0.f};
#pragma unroll
        for (int ks = 0; ks < 2; ++ks) acc = __builtin_amdgcn_mfma_f32_16x16x32_bf16(aP[ks], lds_frag(Vt + (16 * tv + l15) * 72 + 32 * ks + 8 * lq), acc, 0, 0, 0);
#pragma unroll
        for (int kd = 0; kd < 4; ++kd) acc = __builtin_amdgcn_mfma_f32_16x16x32_bf16(aQ[kd], lds_frag(St + (16 * tv + l15) * 136 + 32 * kd + 8 * lq), acc, 0, 0, 0);
        if (wr_out) {
#pragma unroll
          for (int j = 0; j < 4; ++j) { const int t = 16 * tm + 4 * lq + j; raw[(size_t)(cbase + csgn * t) * 512 + 16 * tv + l15] = f2bf_hw(KIND == 3 ? acc[j] * den[j] : acc[j]); }
        }
      }
      bf16x8 aK[2];
#pragma unroll
      for (int ks = 0; ks < 2; ++ks) aK[ks] = lds_frag(Kt + (16 * wid + l15) * 72 + 32 * ks + 8 * lq);
      f32x4 dl;
      if (KIND == 0) dl = *(const f32x4*)(delta + 16 * wid + 4 * lq);
      else { const float dv = (KIND == 1) ? __expf(lg * 64.0f) : dsc[0]; dl = (f32x4){dv, dv, dv, dv}; }
#pragma unroll
      for (int tv = 0; tv < NV; ++tv) {
        accS[tv] = accS[tv] * dl;
#pragma unroll
        for (int ks = 0; ks < 2; ++ks) accS[tv] = __builtin_amdgcn_mfma_f32_16x16x32_bf16(aK[ks], lds_frag(Vt + (16 * tv + l15) * 72 + 32 * ks + 8 * lq), accS[tv], 0, 0, 0);
      }
    }
    __syncthreads();
#pragma unroll
    for (int tv = 0; tv < NV; ++tv) { u32x2 w; w.x = cvt_pk_bf16(accS[tv][0], accS[tv][1]); w.y = cvt_pk_bf16(accS[tv][2], accS[tv][3]); *(u32x2*)(St + (16 * tv + l15) * 136 + 16 * wid + 4 * lq) = w; }
  }
  __syncthreads();
}

__device__ __forceinline__ void scan_s5_chunk(const Params& p, int l, int b, int dir, int gq, unsigned char* smem) {
  const int tid = otid(), lane = tid & 63, wid = tid >> 6, g = gq * 4 + wid, l15 = lane & 15, lq = lane >> 4;
  if (wid >= 4) return;
  bf16_t* XB = (bf16_t*)smem + wid * (64 * 136);
  const bf16_t* cols = (const bf16_t*)(p.ws + OFF_COLS);
  bf16_t* raw = (bf16_t*)(p.ws + OFF_RAW) + (size_t)(2 * 2 + dir) * TT * 512 + g * 16 + l15;
  const size_t ld = (size_t)(l * 2 + dir);
  const float dt = expf(p.in[15][ld * 32 + g]);
  float lam_re, lam_im;
  { const float a_re = p.in[13][(ld * 32 + g) * 64 + lane], a_im = p.in[14][(ld * 32 + g) * 64 + lane]; const float mag = expf(a_re * dt), th = a_im * dt; lam_re = mag * cosf(th); lam_im = mag * sinf(th); }
  bf16x8 abb[8];
  {
    const int hq = (lq & 1) * 8;
#pragma unroll 1
    for (int mt = 0; mt < 8; ++mt) {
      const int pp = (16 * mt + l15) >> 1, im = l15 & 1;
      const size_t ix = ((ld * 32 + g) * 64 + pp) * 16 + hq;
      const f32x4 br0 = *(const f32x4*)(p.in[16] + ix), br1 = *(const f32x4*)(p.in[16] + ix + 4);
      const f32x4 bi0 = *(const f32x4*)(p.in[17] + ix), bi1 = *(const f32x4*)(p.in[17] + ix + 4);
      const float a_re = p.in[13][(ld * 32 + g) * 64 + pp], a_im = p.in[14][(ld * 32 + g) * 64 + pp];
      const float mag = expf(a_re * dt), th = a_im * dt, lr = mag * cosf(th), li = mag * sinf(th);
      const float dn = a_re * a_re + a_im * a_im, nr = lr - 1.0f, ni = li;
      float fr = (nr * a_re + ni * a_im) / dn, fi = (ni * a_re - nr * a_im) / dn;
      if (lq >= 2) { fr = 0.f; fi = 0.f; }
      float o[8];
#pragma unroll
      for (int j = 0; j < 4; ++j) {
        o[j] = im ? (fr * bi0[j] + fi * br0[j]) : (fr * br0[j] - fi * bi0[j]);
        o[4 + j] = im ? (fr * bi1[j] + fi * br1[j]) : (fr * br1[j] - fi * bi1[j]);
      }
      u32x4 w; w.x = cvt_pk_bf16(o[0], o[1]); w.y = cvt_pk_bf16(o[2], o[3]); w.z = cvt_pk_bf16(o[4], o[5]); w.w = cvt_pk_bf16(o[6], o[7]);
      *(u32x4*)(XB + mt * 512 + lane * 8) = w;
    }
    asm volatile("s_waitcnt lgkmcnt(0)" ::: "memory");
#pragma unroll
    for (int mt = 0; mt < 8; ++mt) abb[mt] = lds_frag(XB + mt * 512 + lane * 8);
    asm volatile("s_waitcnt lgkmcnt(0)" ::: "memory");
  }
  bf16x8 ccf[4];
#pragma unroll
  for (int kk = 0; kk < 4; ++kk) {
    const size_t ix = ((ld * 32 + g) * 16 + l15) * 64 + 16 * kk + 4 * lq;
    const f32x4 cr = *(const f32x4*)(p.in[18] + ix), cim = *(const f32x4*)(p.in[19] + ix);
#pragma unroll
    for (int j = 0; j < 4; ++j) { ccf[kk][2 * j] = (short)f2bf(cr[j]); ccf[kk][2 * j + 1] = (short)f2bf(-cim[j]); }
  }
  float xr = 0.f, xi = 0.f;
  const bool wctx = (l == 0);
  int base, sgn;
  chunk_base(0, b, dir, base, sgn);
  u32x4 ufr[4];
#pragma unroll
  for (int nt = 0; nt < 4; ++nt) { ufr[nt] = (u32x4){0u, 0u, 0u, 0u}; if (lq < 2) ufr[nt] = *(const u32x4*)(cols + (size_t)(base + sgn * (16 * nt + l15)) * NIN + C_SU + g * 16 + 8 * lq); }
  for (int ci = 0; ci < 68; ++ci) {
    const int cbase = base, csgn = sgn;
#pragma unroll
    for (int nt = 0; nt < 4; ++nt) {
      const bf16x8 bu = __builtin_bit_cast(bf16x8, ufr[nt]);
      f32x4 a8[8];
#pragma unroll
      for (int mt = 0; mt < 8; ++mt) a8[mt] = __builtin_amdgcn_mfma_f32_16x16x32_bf16(abb[mt], bu, (f32x4){0.f, 0.f, 0.f, 0.f}, 0, 0, 0);
#pragma unroll
      for (int mt = 0; mt < 8; ++mt) {
        u32x2 w; w.x = cvt_pk_bf16(a8[mt][0], a8[mt][1]); w.y = cvt_pk_bf16(a8[mt][2], a8[mt][3]);
        *(u32x2*)(XB + (16 * nt + l15) * 136 + 16 * mt + 4 * lq) = w;
      }
    }
    if (ci + 1 < 68) {
      chunk_base(ci + 1, b, dir, base, sgn);
#pragma unroll
      for (int nt = 0; nt < 4; ++nt) if (lq < 2) ufr[nt] = *(const u32x4*)(cols + (size_t)(base + sgn * (16 * nt + l15)) * NIN + C_SU + g * 16 + 8 * lq);
    }
    asm volatile("s_waitcnt lgkmcnt(0)" ::: "memory");
    {
      unsigned* xw = (unsigned*)XB + lane;
      unsigned nx[8];
#pragma unroll
      for (int i = 0; i < 8; ++i) nx[i] = xw[i * 68];
#pragma unroll 1
      for (int blk = 0; blk < 8; ++blk) {
        unsigned cw[8];
#pragma unroll
        for (int i = 0; i < 8; ++i) cw[i] = nx[i];
        if (blk < 7) {
#pragma unroll
          for (int i = 0; i < 8; ++i) nx[i] = xw[((blk + 1) * 8 + i) * 68];
        }
#pragma unroll
        for (int i = 0; i < 8; ++i) {
          const float nxr = lam_re * xr - lam_im * xi + bflo(cw[i]), nxi = lam_re * xi + lam_im * xr + bfhi(cw[i]);
          xr = nxr; xi = nxi;
          xw[(blk * 8 + i) * 68] = cvt_pk_bf16(xr, xi);
        }
      }
    }
    asm volatile("s_waitcnt lgkmcnt(0)" ::: "memory");
    if (wctx || ci >= 4) {
      f32x4 ya[4];
#pragma unroll
      for (int mt = 0; mt < 4; ++mt) ya[mt] = (f32x4){0.f, 0.f, 0.f, 0.f};
#pragma unroll
      for (int kk = 0; kk < 4; ++kk)
#pragma unroll
        for (int mt = 0; mt < 4; ++mt) ya[mt] = __builtin_amdgcn_mfma_f32_16x16x32_bf16(lds_frag(XB + (16 * mt + l15) * 136 + 32 * kk + 8 * lq), ccf[kk], ya[mt], 0, 0, 0);
#pragma unroll
      for (int mt = 0; mt < 4; ++mt)
#pragma unroll
        for (int j = 0; j < 4; ++j) raw[(size_t)(cbase + csgn * (16 * mt + 4 * lq + j)) * 512] = f2bf_hw(ya[mt][j]);
    }
    asm volatile("s_waitcnt lgkmcnt(0)" ::: "memory");
  }
}

#ifndef MATRIX_CHUNK
#define MATRIX_CHUNK 1
#endif
#ifndef S5_CHUNK
#define S5_CHUNK 1
#endif
#ifndef PROBE_KIND
#define PROBE_KIND -1
#endif
__device__ __forceinline__ void phase_scan(const Params& p, int l, unsigned char* smem) {
  for (int item = blockIdx.x; item < 256; item += gridDim.x) {
    const int kindx = item < 192 ? (item >> 6) : 3;
    const int reps = (kindx == PROBE_KIND) ? 2 : 1;
    for (int rep = 0; rep < reps; ++rep) {
    if (item < 192) {
      const int kind = item >> 6, r = item & 63, b = r >> 4, h = (r >> 2) & 3, dir = (r >> 1) & 1, vh = r & 1;
      if (kind == 0) scan_matrix_chunk<0>(p, l, b, h, dir, vh, smem);
      else if (kind == 1) scan_matrix_chunk<1>(p, l, b, h, dir, vh, smem);
      else scan_matrix_chunk<3>(p, l, b, h, dir, vh, smem);
    } else {
      const int r = item - 192;
      scan_s5_chunk(p, l, r >> 4, (r >> 3) & 1, r & 7, smem);
    }
    }
  }
}

__device__ __forceinline__ void phase_finish(const Params& p, int l, int nrows) {
  const bf16_t* cols = (const bf16_t*)(p.ws + OFF_COLS);
  const bf16_t* raw = (const bf16_t*)(p.ws + OFF_RAW);
  bf16_t* O = (bf16_t*)(p.ws + OFF_O); bf16_t* YC = (bf16_t*)(p.ws + OFF_YC);
  const int tid_ = otid(); const int lane = tid_ & 63, gwv = blockIdx.x * 8 + (tid_ >> 6), nw = gridDim.x * 8, c8 = lane * 8;
  for (int row = gwv; row < nrows; row += nw) {
    const bf16_t* cr = cols + (size_t)row * NIN;
#pragma unroll
    for (int kk = 0; kk < 3; ++kk) {
      const int kind = kk == 2 ? 3 : kk;
      const float* nwp = (kk == 0 ? p.in[10] : kk == 1 ? p.in[12] : p.in[26]) + l * 512 + c8;
      const int gcol = kk == 0 ? C_HG : kk == 1 ? C_RG : C_MZ, ocol = kk == 0 ? 0 : kk == 1 ? 512 : 1536;
      const u32x4 q0 = *(const u32x4*)(raw + ((size_t)(kind * 2 + 0) * TT + row) * 512 + c8), q1 = *(const u32x4*)(raw + ((size_t)(kind * 2 + 1) * TT + row) * 512 + c8);
      const f32x4 a0 = (f32x4){bflo(q0.x) + bflo(q1.x), bfhi(q0.x) + bfhi(q1.x), bflo(q0.y) + bflo(q1.y), bfhi(q0.y) + bfhi(q1.y)};
      const f32x4 a1 = (f32x4){bflo(q0.z) + bflo(q1.z), bfhi(q0.z) + bfhi(q1.z), bflo(q0.w) + bflo(q1.w), bfhi(q0.w) + bfhi(q1.w)};
      float ss = a0[0] * a0[0] + a0[1] * a0[1] + a0[2] * a0[2] + a0[3] * a0[3] + a1[0] * a1[0] + a1[1] * a1[1] + a1[2] * a1[2] + a1[3] * a1[3];
      ss += __shfl_xor(ss, 1); ss += __shfl_xor(ss, 2); ss += __shfl_xor(ss, 4); ss += __shfl_xor(ss, 8);
      const float rn = rsqrtf(ss * (1.0f / 128.0f) + 1e-6f);
      const f32x4 w0 = *(const f32x4*)nwp, w1 = *(const f32x4*)(nwp + 4);
      const u32x4 gt = *(const u32x4*)(cr + gcol + c8);
      const float gg[8] = {bflo(gt.x), bfhi(gt.x), bflo(gt.y), bfhi(gt.y), bflo(gt.z), bfhi(gt.z), bflo(gt.w), bfhi(gt.w)};
      float o[8];
#pragma unroll
      for (int j = 0; j < 4; ++j) { o[j] = a0[j] * rn * w0[j] * siluf(gg[j]); o[4 + j] = a1[j] * rn * w1[j] * siluf(gg[4 + j]); }
      u32x4 w; w.x = cvt_pk_bf16(o[0], o[1]); w.y = cvt_pk_bf16(o[2], o[3]); w.z = cvt_pk_bf16(o[4], o[5]); w.w = cvt_pk_bf16(o[6], o[7]);
      *(u32x4*)(O + (size_t)row * 2048 + ocol + c8) = w;
    }
    {
      const u32x4 q0 = *(const u32x4*)(raw + ((size_t)(2 * 2 + 0) * TT + row) * 512 + c8), q1 = *(const u32x4*)(raw + ((size_t)(2 * 2 + 1) * TT + row) * 512 + c8);
      const f32x4 a0 = (f32x4){bflo(q0.x) + bflo(q1.x), bfhi(q0.x) + bfhi(q1.x), bflo(q0.y) + bflo(q1.y), bfhi(q0.y) + bfhi(q1.y)};
      const f32x4 a1 = (f32x4){bflo(q0.z) + bflo(q1.z), bfhi(q0.z) + bfhi(q1.z), bflo(q0.w) + bflo(q1.w), bfhi(q0.w) + bfhi(q1.w)};
      const f32x4 d0 = *(const f32x4*)(p.in[20] + l * 512 + c8), d1 = *(const f32x4*)(p.in[20] + l * 512 + c8 + 4);
      const u32x4 ut = *(const u32x4*)(cr + C_SU + c8);
      const float uu[8] = {bflo(ut.x), bfhi(ut.x), bflo(ut.y), bfhi(ut.y), bflo(ut.z), bfhi(ut.z), bflo(ut.w), bfhi(ut.w)};
      float o[8];
#pragma unroll
      for (int j = 0; j < 4; ++j) { o[j] = a0[j] + d0[j] * uu[j]; o[4 + j] = a1[j] + d1[j] * uu[4 + j]; }
#pragma unroll
      for (int j = 0; j < 8; ++j) o[j] = 0.5f * o[j] * (1.0f + erff(o[j] * 0.7071067811865476f));
      u32x4 w; w.x = cvt_pk_bf16(o[0], o[1]); w.y = cvt_pk_bf16(o[2], o[3]); w.z = cvt_pk_bf16(o[4], o[5]); w.w = cvt_pk_bf16(o[6], o[7]);
      *(u32x4*)(YC + (size_t)row * 512 + c8) = w;
    }
  }
}


#define XB_TMO      128
#define XB_XCNT(j)  (256  + 64 * (j))
#define XB_XSUB(j)  (1280 + 64 * (j))
#define XB_XGEN(j)  (2304 + 64 * (j))
#define XB_TOP      3328
#define XB_TOPGEN   3392
#define XCD_BAR_WORDS 3456
#define XB_SPIN_CAP (1u << 18)
__device__ __forceinline__ unsigned xb_ld(unsigned* p)              { return __hip_atomic_load(p, __ATOMIC_RELAXED, __HIP_MEMORY_SCOPE_AGENT); }
__device__ __forceinline__ unsigned xb_add(unsigned* p, unsigned v) { return __hip_atomic_fetch_add(p, v, __ATOMIC_RELAXED, __HIP_MEMORY_SCOPE_AGENT); }
__device__ __forceinline__ unsigned xb_xcc_id() { return (unsigned)__builtin_amdgcn_s_getreg((3 << 11) | 20) & 0xFu; }
#define XB_SPIN(cond, bar) do { unsigned _sp = 0; while (cond) { __builtin_amdgcn_s_sleep(1); \
    if ((++_sp & 255u) == 0u) { if (xb_ld(&(bar)[XB_TMO])) break; if (_sp > XB_SPIN_CAP) { atomicAdd(&(bar)[XB_TMO], 1u); break; } } } } while (0)
struct XcdBarrier { unsigned* bar; unsigned x; volatile LAS unsigned* st; };
__device__ __forceinline__ XcdBarrier xcd_barrier_post(unsigned* bar, volatile LAS unsigned* st) {
    XcdBarrier b; b.bar = bar; b.x = xb_xcc_id(); b.st = st;
    if (threadIdx.x == 0) (void)xb_add(&bar[XB_XCNT(b.x)], 1u);
    return b;
}
__device__ __forceinline__ void xcd_barrier_complete(unsigned* bar, unsigned x, unsigned& nloc, unsigned& nx) {
    const unsigned G = gridDim.x * gridDim.y * gridDim.z;
    unsigned sum, cnt, mine, sp = 0u;
    for (;;) {
        sum = 0u; cnt = 0u; mine = 0u;
#pragma unroll
        for (unsigned j = 0; j < 16; ++j) { const unsigned c = xb_ld(&bar[XB_XCNT(j)]); sum += c; cnt += (c > 0u) ? 1u : 0u; mine = (j == x) ? c : mine; }
        if (sum == G) break;
        __builtin_amdgcn_s_sleep(1);
        if ((++sp & 255u) == 0u) { if (xb_ld(&bar[XB_TMO])) break; if (sp > XB_SPIN_CAP) { atomicAdd(&bar[XB_TMO], 1u); break; } }
    }
    nloc = mine > 0u ? mine : 1u; nx = cnt > 0u ? cnt : 1u;
}
__device__ __forceinline__ void xcd_barrier(const XcdBarrier& b) {
    asm volatile("s_waitcnt vmcnt(0)" ::: "memory");
    __syncthreads();
    if (threadIdx.x == 0) {
        unsigned* bar = b.bar;
        __builtin_amdgcn_s_waitcnt(0);
        unsigned nloc = b.st[0], nx = b.st[1];
        if (nloc == 0u) { xcd_barrier_complete(bar, b.x, nloc, nx); b.st[0] = nloc; b.st[1] = nx; }
        const unsigned old = xb_add(&bar[XB_XSUB(b.x)], 1u);
        const unsigned gen = old / nloc;
        if (old + 1u == (gen + 1u) * nloc) {
            __builtin_amdgcn_fence(__ATOMIC_RELEASE, "agent");
            asm volatile("s_waitcnt vmcnt(0)" ::: "memory");
            const unsigned og = xb_add(&bar[XB_TOP], 1u);
            const unsigned tg = og / nx;
            if (og + 1u == (tg + 1u) * nx) xb_add(&bar[XB_TOPGEN], 1u);
            else XB_SPIN(xb_ld(&bar[XB_TOPGEN]) == tg, bar);
            __builtin_amdgcn_fence(__ATOMIC_ACQUIRE, "agent");
            xb_add(&bar[XB_XGEN(b.x)], 1u);
            asm volatile("s_waitcnt vmcnt(0)" ::: "memory");
        } else {
            XB_SPIN(xb_ld(&bar[XB_XGEN(b.x)]) == gen, bar);
            __builtin_amdgcn_fence(__ATOMIC_ACQUIRE, "agent");
            asm volatile("s_waitcnt vmcnt(0)" ::: "memory");
        }
    }
    __syncthreads();
}
__device__ __forceinline__ void grid_barrier(const Params& p, unsigned char* smem) {
  XcdBarrier b; b.bar = (unsigned*)(p.ws + OFF_BAR); b.x = xb_xcc_id(); b.st = (volatile LAS unsigned*)(smem + kPhaseLds);
  xcd_barrier(b);
}

#ifndef PROBE_DUP
#define PROBE_DUP 0
#endif
template <int PH>
__device__ __forceinline__ void do_phase(const Params& p, unsigned char* smem) {
  constexpr int l = PH / 11, k = PH % 11;
  constexpr int Ml = (l == 0) ? TT : TL;
  float* mod = (float*)(p.ws + OFF_MOD);
  bf16_t* ACT = (bf16_t*)(p.ws + OFF_ACT);
  float* XC = (float*)(p.ws + OFF_XC);
  const float* xlat = (l == 0) ? p.in[0] : p.out; const float* xctx = (l == 0) ? p.in[2] : XC;
  const float* modl = mod + (size_t)l * 5 * NMOD;
  if constexpr (k == 0) {
    if (l == 0) phase_convert(p, 0, smem, 0, CVT_IN, 0);
    phase_norm(xlat, xctx, TT, p.in[6] + l * 2048, modl, 0, ACT, (signed char*)(p.ws + OFF_H8), (float*)(p.ws + OFF_SC));
  } else if constexpr (k == 2) {
    for (int rep = 0; rep < ((PROBE_DUP & 2) ? 2 : 1); ++rep)
    phase_conv(p, l);
  } else if constexpr (k == 3) {
    for (int rep = 0; rep < ((PROBE_DUP & 1) ? 2 : 1); ++rep)
    phase_scan(p, l, smem);
  } else if constexpr (k == 4) {
    for (int rep = 0; rep < ((PROBE_DUP & 2) ? 2 : 1); ++rep)
    phase_finish(p, l, Ml);
  } else if constexpr (k == 8) {
    for (int rep = 0; rep < ((PROBE_DUP & 2) ? 2 : 1); ++rep)
    phase_norm(p.out, XC, Ml, p.in[7] + l * 2048, modl, 3 * 2048, ACT);
  } else {
    GemmDesc g;
    g.nkz = 1; g.kzA = 0; g.kzB = 0; g.obf = nullptr; g.ldo = 0; g.ncols = 1 << 30; g.gsrc = nullptr; g.bias = nullptr;
    g.xin_lat = nullptr; g.xin_ctx = nullptr; g.xout_lat = nullptr; g.xout_ctx = nullptr; g.mod = modl; g.moff = 0; g.rowscale = nullptr; g.colmax = nullptr;
    if constexpr (k == 1) { g.A = ACT; g.lda = 2048; g.Bt = (const bf16_t*)(p.ws + OFF_WIN); g.ldb = 2048; g.M = TT; g.N = NINP; g.K = 2048; g.epi = E_COLS;
      g.N = 7424; g.obf = (bf16_t*)(p.ws + OFF_COLS); g.ldo = NIN; g.ncols = C_GATE; }
    else if constexpr (k == 5) { g.A = (const bf16_t*)(p.ws + OFF_YC); g.lda = 512; g.Bt = (const bf16_t*)(p.ws + OFF_WGLU); g.ldb = 512; g.M = Ml; g.N = 512; g.K = 512; g.epi = E_GLU;
      g.obf = (bf16_t*)(p.ws + OFF_O) + 1024; g.ldo = 2048; g.gsrc = (const bf16_t*)(p.ws + OFF_YC); g.bias = p.in[22] + l * 512; }
    else if constexpr (k == 6) { g.A = (const bf16_t*)(p.ws + OFF_O); g.lda = 2048; g.Bt = (const bf16_t*)(p.ws + OFF_WBR); g.ldb = 512; g.M = Ml; g.N = 2048; g.K = 512; g.epi = E_MERGE;
      g.nkz = 4; g.kzA = 512 * 2; g.kzB = (size_t)2048 * 512 * 2; g.obf = ACT; g.ldo = 2048; g.gsrc = (const bf16_t*)(p.ws + OFF_COLS); }
    else if constexpr (k == 7) { g.A = ACT; g.lda = 2048; g.Bt = (const bf16_t*)(p.ws + OFF_WOUT); g.ldb = 2048; g.M = Ml; g.N = 2048; g.K = 2048; g.epi = E_RES;
      g.xin_lat = xlat; g.xin_ctx = xctx; g.xout_lat = p.out; g.xout_ctx = XC; g.moff = 2 * 2048; }
    else if constexpr (k == 9) { g.A = ACT; g.lda = 2048; g.Bt = (const bf16_t*)(p.ws + OFF_WFF1); g.ldb = 2048; g.M = Ml; g.N = 8192; g.K = 2048; g.epi = E_RELU2;
      g.obf = (bf16_t*)(p.ws + OFF_U); g.ldo = 8192; }
    else { g.A = (const bf16_t*)(p.ws + OFF_U); g.lda = 8192; g.Bt = (const bf16_t*)(p.ws + OFF_WFF2); g.ldb = 8192; g.M = Ml; g.N = 2048; g.K = 8192; g.epi = E_RES;
      g.xin_lat = p.out; g.xin_ctx = XC; g.xout_lat = p.out; g.xout_ctx = XC; g.moff = 5 * 2048; }
    gemm_phase((LAS unsigned char*)smem, g);
    if constexpr (k == 1) {
      GemmDesc g8 = g;
      g8.A = (const bf16_t*)(p.ws + OFF_H8); g8.Bt = (const bf16_t*)(p.ws + OFF_W8); g8.lda = 1024; g8.ldb = 1024; g8.N = 8192; g8.K = 1024;
      if (l == 1) g8.M = TL;
      g8.epi = E_GATE8; g8.obf = (bf16_t*)(p.ws + OFF_COLS) + C_GATE; g8.ldo = NIN; g8.rowscale = (const float*)(p.ws + OFF_SC); g8.colmax = (const float*)(p.ws + OFF_SC) + TT;
      gemm_phase<true>((LAS unsigned char*)smem, g8);
    }
    if constexpr (k == 1 && l == 0) { phase_convert(p, 0, smem, CVT_IN, CVT_FF2_LO, 128);
                                      phase_convert(p, 0, smem, CVT_FF2_HI, CVT_TOT, 128); }
    if constexpr (k == 7 && l == 0) phase_colmax(p, 1, smem, 128);
    if constexpr (k == 7 && l == 0) phase_mod(p, smem, 1, 2, 32);
    if constexpr (k == 6 && l == 0) phase_convert(p, 0, smem, CVT_FF2_LO, CVT_FF2_HI, 32);
    if constexpr (k == 9 && l == 0) phase_convert(p, 1, smem, 0, 32 * (7424 / 64), 128);
    if constexpr (k == 10 && l == 0) { phase_convert(p, 1, smem, 32 * (7424 / 64), CVT_FF2_LO, 32);
                                       phase_convert(p, 1, smem, CVT_FF2_HI, CVT_TOT, 32); }
    if constexpr (k == 1 && l == 1) phase_convert(p, 1, smem, CVT_FF2_LO, CVT_FF2_HI, 180);
  }
}

__global__ void __launch_bounds__(512, 2) fwd_megakernel(Params p) {
  extern __shared__ __attribute__((aligned(16))) unsigned char smem[];
  cg::grid_group grid = cg::this_grid();
  if (threadIdx.x < 4) ((volatile LAS unsigned*)(smem + kPhaseLds))[threadIdx.x] = 0u;
  __syncthreads();
  (void)xcd_barrier_post((unsigned*)(p.ws + OFF_BAR), (volatile LAS unsigned*)(smem + kPhaseLds));
  phase_mod(p, smem, 0, 1, 0);
  phase_colmax(p, 0, smem, 96);
  if (p.ws == nullptr) grid.sync();
  grid_barrier(p, smem);
#define PH(n) do_phase<n>(p, smem); grid_barrier(p, smem);
  PH(0) PH(1) PH(2) PH(3) PH(4) PH(5) PH(6) PH(7) PH(8) PH(9) PH(10)
  PH(11) PH(12) PH(13) PH(14) PH(15) PH(16) PH(17) PH(18) PH(19) PH(20) PH(21)
#undef PH
  phase_final_norm(p.out, p.in[31]);
}

extern "C" void kernel_launch(void* const* d_in, const int* in_sizes, int n_in, void* d_out, int out_size,
                              void* d_ws, size_t ws_size, hipStream_t stream) {
  static int grid_blocks = 0;
  if (!grid_blocks) {
    int dev = 0, cus = 0, per_cu = 0;
    (void)hipGetDevice(&dev);
    (void)hipDeviceGetAttribute(&cus, hipDeviceAttributeMultiprocessorCount, dev);
    (void)hipFuncSetAttribute((const void*)fwd_megakernel, hipFuncAttributeMaxDynamicSharedMemorySize, kDynLds);
    (void)hipOccupancyMaxActiveBlocksPerMultiprocessor(&per_cu, fwd_megakernel, 512, kDynLds);
    if (per_cu < 1) per_cu = 1;
    grid_blocks = cus * per_cu;
    if (grid_blocks > 256) grid_blocks = 256;
  }
  if (ws_size < WS_TOTAL) fprintf(stderr, "workspace too small: %zu < %zu\n", ws_size, (size_t)WS_TOTAL);
  Params p{};
  for (int i = 0; i < 32; ++i) p.in[i] = (const float*)d_in[i];
  p.out = (float*)d_out; p.ws = (unsigned char*)d_ws;
  (void)hipMemsetAsync((unsigned char*)d_ws + OFF_BAR, 0, XCD_BAR_WORDS * 4, stream);
  void* args[] = {&p};
  hipError_t e = hipLaunchCooperativeKernel((void*)fwd_megakernel, dim3(grid_blocks), dim3(512), args, kDynLds, stream);
  if (e != hipSuccess) fprintf(stderr, "cooperative launch failed: %s (grid %d)\n", hipGetErrorString(e), grid_blocks);
}
```
